# Optimizing an MI355X kernel written in HIP

```python
import math
import jax, jax.numpy as jnp
from jax import lax
import numpy as np

D_MODEL = 1024
BATCH = 4
SEQ = 8192
DEPTH = 1

N_HEADS = 8
HEAD_DIM = 64
ATTN_WIDTH = N_HEADS * HEAD_DIM
DILATIONS = ((128, 1), (512, 4), (2048, 16))
BLK = 128
ROPE_THETA = 10000.0
GMLP_GROUPS = 4
GMLP_WIDTH = D_MODEL // 2
GMLP_GROUP_DIM = GMLP_WIDTH // GMLP_GROUPS
CHUNK = 128
IN_COLS = 4 * ATTN_WIDTH + 3 * GMLP_WIDTH
MIX_WIDTH = ATTN_WIDTH + GMLP_WIDTH
PLE_DIM = 256
EPS = 1e-6
NEG = -1e30

kernel_name = "hybrid_dilated_attn_gmlp_parallel_heads"


def _rmsnorm(x, g):
    xf = x.astype(jnp.float32)
    y = xf * lax.rsqrt(jnp.mean(xf * xf, axis=-1, keepdims=True) + EPS)
    return (y * g.astype(jnp.float32)).astype(x.dtype)


def _layernorm(x, g, b):
    xf = x.astype(jnp.float32)
    mu = jnp.mean(xf, axis=-1, keepdims=True)
    xc = xf - mu
    var = jnp.mean(xc * xc, axis=-1, keepdims=True)
    y = xc * lax.rsqrt(var + EPS)
    return (y * g.astype(jnp.float32) + b.astype(jnp.float32)).astype(x.dtype)


def _rope(t, positions):
    half = HEAD_DIM // 2
    inv_freq = jnp.exp(-math.log(ROPE_THETA) * jnp.arange(half, dtype=jnp.float32) / half)
    ang = positions.astype(jnp.float32)[..., None] * inv_freq
    c = jnp.cos(ang)[:, :, None, :]
    s = jnp.sin(ang)[:, :, None, :]
    tf = t.astype(jnp.float32)
    t1, t2 = tf[..., :half], tf[..., half:]
    return jnp.concatenate([t1 * c - t2 * s, t2 * c + t1 * s], axis=-1).astype(t.dtype)


def _dilated_branch(q, k, v, window, dilation):
    B, S, H, D = q.shape
    r = dilation
    L = S // r
    n_back = window // r
    Lp = ((L + BLK - 1) // BLK) * BLK
    nb = Lp // BLK

    def split(t):
        t = t.reshape(B, L, r, H, D).transpose(0, 2, 1, 3, 4).reshape(B * r, L, H, D)
        return jnp.pad(t, ((0, 0), (0, Lp - L), (0, 0), (0, 0)))

    qs = split(q).reshape(B * r, nb, BLK, H, D)
    kb = split(k).reshape(B * r, nb, BLK, H, D)
    vb = split(v).reshape(B * r, nb, BLK, H, D)
    k_prev = jnp.pad(kb, ((0, 0), (1, 0), (0, 0), (0, 0), (0, 0)))[:, :-1]
    v_prev = jnp.pad(vb, ((0, 0), (1, 0), (0, 0), (0, 0), (0, 0)))[:, :-1]
    kk = jnp.concatenate([k_prev, kb], axis=2)
    vv = jnp.concatenate([v_prev, vb], axis=2)

    scores = jnp.einsum('nbqhd,nbkhd->nbhqk', qs, kk).astype(jnp.float32) * (HEAD_DIM ** -0.5)
    dist = (jnp.arange(BLK)[:, None] + BLK) - jnp.arange(2 * BLK)[None, :]
    band = (dist >= 0) & (dist <= n_back)
    key_idx = jnp.arange(nb)[:, None] * BLK - BLK + jnp.arange(2 * BLK)[None, :]
    valid = band[None, :, :] & (key_idx >= 0)[:, None, :]
    scores = jnp.where(valid[None, :, None], scores, NEG)
    m = jnp.max(scores, axis=-1, keepdims=True)
    e = jnp.exp(scores - m)
    den = jnp.sum(e, axis=-1, keepdims=True)
    out = jnp.einsum('nbhqk,nbkhd->nbqhd', (e / den).astype(v.dtype), vv)
    lse = (m + jnp.log(den))[..., 0]
    lse = lse.transpose(0, 1, 3, 2).reshape(B * r, Lp, H)[:, :L]
    out = out.reshape(B * r, Lp, H, D)[:, :L]
    out = out.reshape(B, r, L, H, D).transpose(0, 2, 1, 3, 4).reshape(B, S, H, D)
    lse = lse.reshape(B, r, L, H).transpose(0, 2, 1, 3).reshape(B, S, H)
    return out, lse


def _dilated_attention(q, k, v):
    outs, lses = [], []
    for window, dilation in DILATIONS:
        o, l = _dilated_branch(q, k, v, window, dilation)
        outs.append(o)
        lses.append(l)
    w = jax.nn.softmax(jnp.stack(lses, axis=0), axis=0)
    o = jnp.sum(w[..., None] * jnp.stack(outs, axis=0).astype(jnp.float32), axis=0)
    return o.astype(q.dtype)


def _gmlp_spatial(u, v, w_s, b_s, ln_g, ln_b):
    B, S, _ = u.shape
    u = jax.nn.gelu(u)
    v = _layernorm(jax.nn.gelu(v), ln_g, ln_b)
    vr = v.reshape(B, S // CHUNK, CHUNK, GMLP_GROUPS, GMLP_GROUP_DIM)
    ws = w_s * jnp.tril(jnp.ones((CHUNK, CHUNK), dtype=w_s.dtype))[None]
    sv = jnp.einsum('gts,bcsgd->bctgd', ws, vr) + b_s.T[None, None, :, :, None]
    return u * sv.reshape(B, S, GMLP_WIDTH)


def setup_inputs(seed: int = 0) -> dict:
    key = jax.random.key(seed)
    ks = jax.random.split(key, 16)
    f32 = jnp.float32
    nrm = lambda k, shape, scale: jax.random.normal(k, shape, f32) * scale
    x = jax.random.normal(ks[0], (BATCH, SEQ, D_MODEL), f32)
    p = jax.random.normal(ks[1], (DEPTH, BATCH, SEQ, PLE_DIM), f32)
    positions = jnp.broadcast_to(jnp.arange(SEQ, dtype=jnp.int32)[None, :], (BATCH, SEQ))
    return {
        "x": x,
        "p": p,
        "positions": positions,
        "g_in": 1.0 + nrm(ks[2], (DEPTH, D_MODEL), 0.01),
        "w_in": nrm(ks[3], (DEPTH, D_MODEL, IN_COLS), D_MODEL ** -0.5),
        "q_norm": 1.0 + nrm(ks[4], (DEPTH, HEAD_DIM), 0.01),
        "k_norm": 1.0 + nrm(ks[5], (DEPTH, HEAD_DIM), 0.01),
        "w_spatial": nrm(ks[6], (DEPTH, GMLP_GROUPS, CHUNK, CHUNK), 0.5 * CHUNK ** -0.5),
        "b_spatial": 1.0 + nrm(ks[7], (DEPTH, GMLP_GROUPS, CHUNK), 0.1),
        "ln_v_g": 1.0 + nrm(ks[8], (DEPTH, GMLP_WIDTH), 0.01),
        "ln_v_b": nrm(ks[9], (DEPTH, GMLP_WIDTH), 0.01),
        "w_out": nrm(ks[10], (DEPTH, MIX_WIDTH, D_MODEL), MIX_WIDTH ** -0.5),
        "g_ple": 1.0 + nrm(ks[11], (DEPTH, D_MODEL), 0.01),
        "w_ple_gate": nrm(ks[12], (DEPTH, D_MODEL, D_MODEL), D_MODEL ** -0.5),
        "b_ple_gate": nrm(ks[13], (DEPTH, D_MODEL), 0.01),
        "w_ple_proj": nrm(ks[14], (DEPTH, PLE_DIM, D_MODEL), PLE_DIM ** -0.5),
    }


def reference(x, p, positions, g_in, w_in, q_norm, k_norm, w_spatial, b_spatial,
              ln_v_g, ln_v_b, w_out, g_ple, w_ple_gate, b_ple_gate, w_ple_proj):
    B, S, _ = x.shape
    h = x
    for i in range(DEPTH):
        a = _rmsnorm(h, g_in[i])
        z = jnp.einsum('bsd,de->bse', a, w_in[i])
        q, k, v, gate_b, u_a, v_a, gate_a = jnp.split(
            z, np.cumsum([ATTN_WIDTH] * 4 + [GMLP_WIDTH] * 2).tolist(), axis=-1)
        q = _rope(_rmsnorm(q.reshape(B, S, N_HEADS, HEAD_DIM), q_norm[i]), positions)
        k = _rope(_rmsnorm(k.reshape(B, S, N_HEADS, HEAD_DIM), k_norm[i]), positions)
        v = v.reshape(B, S, N_HEADS, HEAD_DIM)
        o_b = _dilated_attention(q, k, v).reshape(B, S, ATTN_WIDTH) * jax.nn.silu(gate_b)
        o_a = _gmlp_spatial(u_a, v_a, w_spatial[i], b_spatial[i], ln_v_g[i], ln_v_b[i]) * jax.nn.silu(gate_a)
        mixed = jnp.concatenate([o_b, o_a], axis=-1)
        h = h + jnp.einsum('bse,ed->bsd', mixed, w_out[i])
        gate = jax.nn.sigmoid(jnp.einsum('bsd,de->bse', _rmsnorm(h, g_ple[i]), w_ple_gate[i]) + b_ple_gate[i])
        h = h + gate * jnp.einsum('bsp,pd->bsd', p[i], w_ple_proj[i])
    return h
```

```cpp
#define MK_N_LAUNCHES 1
#include <hip/hip_runtime.h>
#include <cstdio>
#include <cstdint>
namespace pg8 {
#define PG8_LAS __attribute__((address_space(3)))
typedef unsigned short bf16_t;
typedef short bf16x8 __attribute__((ext_vector_type(8)));
typedef float f32x4 __attribute__((ext_vector_type(4)));
typedef unsigned u32x4 __attribute__((ext_vector_type(4)));
constexpr int BM = 256, BK = 64, HALF = 128, HTB = HALF * BK * 2  , STAGE_BYTES = 8 * HTB, NXCD = 8, WGM = 8;

__host__ __device__ __forceinline__ int lds_byte(int r, int c) { const int st = (r >> 4) * 2 + (c >> 5), rr = r & 15, cc = c & 31, ob = rr * 64 + cc * 2; return st * 1024 + (ob ^ (((ob >> 9) & 1) << 5)); }
__host__ __device__ __forceinline__ void stage_rc(int b, int& R, int& C) { const int st = b / 1024, sb = b % 1024, swz = sb ^ (((sb >> 9) & 1) << 5); R = (st >> 1) * 16 + swz / 64; C = (st & 1) * 32 + (swz % 64) / 2; }
__host__ __device__ __forceinline__ int perm32(int rho) { const int n = rho >> 4, i = rho & 15; return 8 * (i >> 2) + 4 * n + (i & 3); }

struct Unit { int pm, pn; };
struct Gemm { const bf16_t* A; const bf16_t* Bt; int M, N, K; };

struct StaticOrder {
    int nM, nN, nwg, G, c;
    __host__ __device__ void init(int M, int N, int G_, int c_) { nM = M / BM; nN = N / BM; nwg = nM * nN; G = G_; c = c_; }
    __host__ __device__ bool next(int i, Unit& u) const {
        const long L = (long)i * G + c; if (L >= nwg) return false;
        int wgid = (int)L; { const int q = nwg / NXCD, r = nwg % NXCD, xcd = wgid % NXCD, off = wgid / NXCD; wgid = (xcd < r ? xcd * (q + 1) : r * (q + 1) + (xcd - r) * q) + off; }
        const int nig = WGM * nN, gid = wgid / nig, fm = gid * WGM, gsz = (nM - fm) < WGM ? (nM - fm) : WGM;
        u.pm = fm + ((wgid % nig) % gsz); u.pn = (wgid % nig) / gsz; return true;
    }
    __device__ __forceinline__ void a_ready(const Unit&) const {}
    __device__ __forceinline__ void done(const Unit&) const {}
};

typedef float f32x2c_t __attribute__((ext_vector_type(2))); typedef __bf16 bf16x2c_t __attribute__((ext_vector_type(2)));
__device__ __forceinline__ unsigned cvt_pk_bf16(float lo, float hi) { f32x2c_t v = {lo, hi}; bf16x2c_t b = __builtin_convertvector(v, bf16x2c_t); return __builtin_bit_cast(unsigned, b); }
typedef float f32x2 __attribute__((ext_vector_type(2)));
__device__ __forceinline__ f32x2 gelu_pk(f32x2 v) {
    const f32x2 av = __builtin_elementwise_abs(v), d = av * 0.2316418882f + 1.0f;
    f32x2 t; t.x = __builtin_amdgcn_rcpf(d.x); t.y = __builtin_amdgcn_rcpf(d.y);
    f32x2 q = t * 0.5307027145f + (-0.7265760135f); q = q * t + 0.7107068705f; q = q * t + (-0.142248368f); q = q * t + 0.127414796f; q = q * t;
    const f32x2 s = (v * v) * (-0.72134752044f);
    f32x2 e; e.x = __builtin_amdgcn_exp2f(s.x); e.y = __builtin_amdgcn_exp2f(s.y);
    const f32x2 m = v * (q * e), r = v - m;
    f32x2 o; o.x = v.x < 0.f ? m.x : r.x; o.y = v.y < 0.f ? m.y : r.y; return o;
}

template <int ACT  > struct EpiBf16 {
    static constexpr bool PERM = true, AFTER_DRAIN = false; static_assert(ACT == 0 || ACT == 1, "EpiBf16: ACT is 0 (none) or 1 (gelu_pk)");
    bf16_t* O; int ldc; const float* bias; int split_cols; size_t split_stride; float scale0;
    __device__ __forceinline__ void operator()(const f32x4 (&acc)[2][2][4][2], const Unit& u, int wr, int wc, int fr, int fq) const {
        const int row0 = u.pm * BM + wr * 64 + fr; int colt = u.pn * BM; bf16_t* base = O;
        float sc = 1.f; if (split_cols) { const int t = colt / split_cols; base += (size_t)t * split_stride; colt -= t * split_cols; if (t == 0) sc = scale0; }
        const int col0 = colt + wc * 32 + 8 * fq, bcol0 = u.pn * BM + wc * 32 + 8 * fq;
        f32x4 bv[2][2];
#pragma unroll
        for (int bj = 0; bj < 2; ++bj)
#pragma unroll
            for (int n = 0; n < 2; ++n) bv[bj][n] = bias ? *(const f32x4*)(bias + bcol0 + bj * HALF + 4 * n) : (f32x4){0.f, 0.f, 0.f, 0.f};
#pragma unroll
        for (int ai = 0; ai < 2; ++ai)
#pragma unroll
            for (int m = 0; m < 4; ++m) { bf16_t* rowp = base + (size_t)(row0 + ai * HALF + m * 16) * ldc + col0;
#pragma unroll
                for (int bj = 0; bj < 2; ++bj) { f32x4 v0 = acc[ai][bj][m][0] + bv[bj][0], v1 = acc[ai][bj][m][1] + bv[bj][1];
                    if (ACT == 1) { f32x2 a = gelu_pk((f32x2){v0[0], v0[1]}), b = gelu_pk((f32x2){v0[2], v0[3]}), c = gelu_pk((f32x2){v1[0], v1[1]}), d = gelu_pk((f32x2){v1[2], v1[3]});
                        v0 = (f32x4){a.x, a.y, b.x, b.y}; v1 = (f32x4){c.x, c.y, d.x, d.y}; }
                    v0 = v0 * sc; v1 = v1 * sc; u32x4 w; w.x = cvt_pk_bf16(v0[0], v0[1]); w.y = cvt_pk_bf16(v0[2], v0[3]); w.z = cvt_pk_bf16(v1[0], v1[1]); w.w = cvt_pk_bf16(v1[2], v1[3]);
                    *(u32x4*)(rowp + bj * HALF) = w; } }
    }
};
template <class Epi, class Sched, bool ALIGN_EPI = false, bool SP2 = false>
__device__ __forceinline__ void gemm_phase(PG8_LAS unsigned char* lds, const Gemm g, const Sched& S, const Epi& E) {
    const int tid = threadIdx.x, wid = __builtin_amdgcn_readfirstlane(tid >> 6), lane = tid & 63, wr = wid >> 2, wc = wid & 3, fr = lane & 15, fq = lane >> 4;
    const int K = g.K, nt = K / BK;
    unsigned voffA[2], voffB[2];
#pragma unroll
    for (int i = 0; i < 2; ++i) { int R, C; stage_rc(tid * 16 + i * 8192, R, C); const int Rb = Epi::PERM ? ((R & ~31) + perm32(R & 31)) : R;
        voffA[i] = (unsigned)(R * K + C) * 2u; voffB[i] = (unsigned)(Rb * K + C) * 2u; }
    const size_t kstep = (size_t)(BK * 2);
    const size_t hstep = (size_t)HALF * K * 2;
    const size_t tstep = 2 * hstep;
    const unsigned ldsw = (unsigned)wid * 1024u;
    const int aoff = lds_byte(wr * 64 + fr, fq * 8), boff = lds_byte(wc * 32 + fr, fq * 8);
#define PG8_SA(b, h) (((b) * 2 + (h)) * HTB)
#define PG8_SB(b, h) ((4 + (b) * 2 + (h)) * HTB)
#define PG8_STAGE(bufoff, gbase, voff) do { _Pragma("unroll") for (int _i = 0; _i < 2; ++_i) \
        __builtin_amdgcn_global_load_lds((const unsigned*)((const char*)(gbase) + (voff)[_i]), (PG8_LAS unsigned*)(lds + (bufoff) + ldsw + _i * 8192), 16, 0, 0); } while (0)
#define PG8_LDA(dst, b, h) do { _Pragma("unroll") for (int m = 0; m < 4; ++m) _Pragma("unroll") for (int k = 0; k < 2; ++k) dst[m][k] = *(const PG8_LAS bf16x8*)(lds + PG8_SA(b, h) + aoff + m * 2048 + k * 1024); } while (0)
#define PG8_LDB(dst, b, h) do { _Pragma("unroll") for (int n = 0; n < 2; ++n) _Pragma("unroll") for (int k = 0; k < 2; ++k) dst[n][k] = *(const PG8_LAS bf16x8*)(lds + PG8_SB(b, h) + boff + n * 2048 + k * 1024); } while (0)
#define PG8_MMA(ai, bj, At, Bt) do { __builtin_amdgcn_s_setprio(1); _Pragma("unroll") for (int m = 0; m < 4; ++m) _Pragma("unroll") for (int n = 0; n < 2; ++n) _Pragma("unroll") for (int k = 0; k < 2; ++k) \
        acc[ai][bj][m][n] = __builtin_amdgcn_mfma_f32_16x16x32_bf16(Bt[n][k], At[m][k], acc[ai][bj][m][n], 0, 0, 0); __builtin_amdgcn_s_setprio(0); } while (0)
#define PG8_WAIT_V(n) asm volatile("s_waitcnt vmcnt(" #n ")" ::: "memory")
#define PG8_WAIT_L(n) asm volatile("s_waitcnt lgkmcnt(" #n ")" ::: "memory")
#define PG8_BAR __builtin_amdgcn_s_barrier()
#define PG8_SCHED __builtin_amdgcn_sched_barrier(0)
    Unit cur, nxt; int ui = 0;
    if (!S.next(0, cur)) return;
    f32x4 acc[2][2][4][2];
#pragma unroll
    for (int a = 0; a < 2; ++a)
#pragma unroll
        for (int b = 0; b < 2; ++b)
#pragma unroll
            for (int m = 0; m < 4; ++m)
#pragma unroll
                for (int n = 0; n < 2; ++n) acc[a][b][m][n] = (f32x4){0.f, 0.f, 0.f, 0.f};
    bf16x8 At[4][2], B0[2][2], B1[2][2];
    const char* cA = (const char*)g.A + (size_t)cur.pm * tstep; const char* cB = (const char*)g.Bt + (size_t)cur.pn * tstep;
    S.a_ready(cur);
    if constexpr (SP2) {
        PG8_STAGE(PG8_SB(0, 0), cB, voffB); PG8_STAGE(PG8_SB(0, 1), cB + hstep, voffB); PG8_STAGE(PG8_SA(0, 0), cA, voffA); PG8_STAGE(PG8_SA(0, 1), cA + hstep, voffA);
        if (wr == 1) PG8_BAR;
        PG8_WAIT_V(2); PG8_BAR;
        PG8_STAGE(PG8_SB(1, 0), cB + kstep, voffB); PG8_STAGE(PG8_SA(1, 0), cA + kstep, voffA); PG8_STAGE(PG8_SB(1, 1), cB + hstep + kstep, voffB);
        PG8_WAIT_V(6); PG8_BAR;
    } else {
        PG8_STAGE(PG8_SB(0, 0), cB, voffB); PG8_STAGE(PG8_SA(0, 0), cA, voffA); PG8_STAGE(PG8_SB(0, 1), cB + hstep, voffB); PG8_STAGE(PG8_SA(0, 1), cA + hstep, voffA);
        if (wr == 1) PG8_BAR;
        PG8_WAIT_V(4); PG8_BAR;
        PG8_STAGE(PG8_SB(1, 0), cB + kstep, voffB); PG8_STAGE(PG8_SA(1, 0), cA + kstep, voffA); PG8_STAGE(PG8_SB(1, 1), cB + hstep + kstep, voffB);
        PG8_WAIT_V(6); PG8_BAR;
    }
    for (;;) {
        const bool has_next = S.next(ui + 1, nxt);
        const char* nA = has_next ? (const char*)g.A + (size_t)nxt.pm * tstep : cA; const char* nB = has_next ? (const char*)g.Bt + (size_t)nxt.pn * tstep : cB;
        for (int t = 0; t < nt; t += 2) {
            const bool last = (t == nt - 2);
            const char* a1 = cA + (size_t)(t + 1) * kstep;
            const char* a2 = last ? nA : cA + (size_t)(t + 2) * kstep; const char* b2 = last ? nB : cB + (size_t)(t + 2) * kstep;
            const char* a3 = a2 + kstep; const char* b3 = b2 + kstep;
            if (last && has_next) S.a_ready(nxt);
            if constexpr (SP2) {
            PG8_LDB(B0, 0, 0); PG8_LDB(B1, 0, 1); PG8_SCHED; PG8_LDA(At, 0, 0); PG8_STAGE(PG8_SA(1, 1), a1 + hstep, voffA);
            PG8_WAIT_V(8); PG8_WAIT_L(0); PG8_BAR; PG8_MMA(0, 0, At, B0); PG8_MMA(0, 1, At, B1); PG8_BAR; PG8_SCHED;
            PG8_LDA(At, 0, 1); PG8_STAGE(PG8_SB(0, 0), b2, voffB); PG8_STAGE(PG8_SB(0, 1), b2 + hstep, voffB); PG8_STAGE(PG8_SA(0, 0), a2, voffA);
            PG8_WAIT_V(8); PG8_WAIT_L(0); PG8_BAR; PG8_MMA(1, 0, At, B0); PG8_MMA(1, 1, At, B1); PG8_BAR; PG8_SCHED;
            PG8_LDB(B0, 1, 0); PG8_LDB(B1, 1, 1); PG8_SCHED; PG8_LDA(At, 1, 0); PG8_STAGE(PG8_SA(0, 1), a2 + hstep, voffA);
            PG8_WAIT_V(8); PG8_WAIT_L(0); PG8_BAR; PG8_MMA(0, 0, At, B0); PG8_MMA(0, 1, At, B1); PG8_BAR; PG8_SCHED;
            PG8_LDA(At, 1, 1); PG8_STAGE(PG8_SB(1, 0), b3, voffB); PG8_STAGE(PG8_SB(1, 1), b3 + hstep, voffB); PG8_STAGE(PG8_SA(1, 0), a3, voffA);
            PG8_WAIT_V(8); PG8_WAIT_L(0); PG8_BAR; PG8_MMA(1, 0, At, B0); PG8_MMA(1, 1, At, B1); PG8_BAR; PG8_SCHED;
            } else {
            PG8_LDB(B0, 0, 0); PG8_SCHED; PG8_LDA(At, 0, 0); PG8_STAGE(PG8_SA(1, 1), a1 + hstep, voffA);
            PG8_WAIT_L(8); PG8_BAR; PG8_WAIT_L(0); PG8_MMA(0, 0, At, B0); PG8_BAR; PG8_SCHED;
            PG8_LDB(B1, 0, 1); PG8_STAGE(PG8_SB(0, 0), b2, voffB);
            PG8_BAR; PG8_WAIT_L(0); PG8_MMA(0, 1, At, B1); PG8_BAR;
            PG8_LDA(At, 0, 1); PG8_STAGE(PG8_SA(0, 0), a2, voffA);
            PG8_BAR; PG8_WAIT_L(0); PG8_MMA(1, 0, At, B0); PG8_BAR; PG8_SCHED;
            PG8_STAGE(PG8_SB(0, 1), b2 + hstep, voffB);
            PG8_WAIT_V(6); PG8_BAR; PG8_MMA(1, 1, At, B1); PG8_BAR;
            PG8_LDB(B0, 1, 0); PG8_SCHED; PG8_LDA(At, 1, 0); PG8_STAGE(PG8_SA(0, 1), a2 + hstep, voffA);
            PG8_WAIT_L(8); PG8_BAR; PG8_WAIT_L(0); PG8_MMA(0, 0, At, B0); PG8_BAR; PG8_SCHED;
            PG8_LDB(B1, 1, 1); PG8_STAGE(PG8_SB(1, 0), b3, voffB);
            PG8_BAR; PG8_WAIT_L(0); PG8_MMA(0, 1, At, B1); PG8_BAR;
            PG8_LDA(At, 1, 1); PG8_STAGE(PG8_SA(1, 0), a3, voffA);
            PG8_BAR; PG8_WAIT_L(0); PG8_MMA(1, 0, At, B0); PG8_BAR; PG8_SCHED;
            PG8_STAGE(PG8_SB(1, 1), b3 + hstep, voffB);
            PG8_WAIT_V(6); PG8_BAR; PG8_MMA(1, 1, At, B1); PG8_BAR;
            }
        }
        if constexpr (ALIGN_EPI) { if (wr == 0) PG8_BAR; }
        if constexpr (!Epi::AFTER_DRAIN) { E(acc, cur, wr, wc, fr, fq); S.done(cur); }
        if (!has_next) break;
#pragma unroll
        for (int a = 0; a < 2; ++a)
#pragma unroll
            for (int b = 0; b < 2; ++b)
#pragma unroll
                for (int m = 0; m < 4; ++m)
#pragma unroll
                    for (int n = 0; n < 2; ++n) acc[a][b][m][n] = (f32x4){0.f, 0.f, 0.f, 0.f};
        cur = nxt; cA = nA; cB = nB; ++ui;
        if constexpr (ALIGN_EPI) { if (wr == 1) PG8_BAR; }
    }
    PG8_WAIT_V(0);
    if constexpr (!ALIGN_EPI) { if (wr == 0) PG8_BAR; }
    PG8_BAR;
    if constexpr (Epi::AFTER_DRAIN) { E.fused(acc, cur, wr, wc, fr, fq, lds, wid, lane); S.done(cur); }
#undef PG8_SA
#undef PG8_SB
#undef PG8_STAGE
#undef PG8_LDA
#undef PG8_LDB
#undef PG8_MMA
#undef PG8_WAIT_V
#undef PG8_WAIT_L
#undef PG8_BAR
#undef PG8_SCHED
}
}

#ifndef PG8_SP2
#define PG8_SP2 true
#endif
#ifndef PG8_ALIGN
#define PG8_ALIGN true
#endif
namespace pg8 {
constexpr float kLog2e = 1.4426950408889634f;
__device__ __forceinline__ float sigmoid_f(float x) { return __builtin_amdgcn_rcpf(1.0f + __builtin_amdgcn_exp2f(-kLog2e * x)); }
typedef unsigned u32x2 __attribute__((ext_vector_type(2)));

struct EpiIn {
    static constexpr bool PERM = true, AFTER_DRAIN = false;
    bf16_t *Q, *K, *V, *GB, *U, *VA, *GA; const float *qn, *kn; const int* pos; float qscale;
    __device__ __forceinline__ void operator()(const f32x4 (&acc)[2][2][4][2], const Unit& u, int wr, int wc, int fr, int fq) const {
        const int pn = u.pn;
        const int row0 = u.pm * BM + wr * 64 + fr;
        if (pn < 4) {
            const bool isq = pn < 2;
            const int head = (pn & 1) * 4 + wc;
            const float* gs = isq ? qn : kn; bf16_t* dst = isq ? Q : K; const float sc = isq ? qscale : 1.0f;
            f32x4 g[2][2], invf[2];
#pragma unroll
            for (int bj = 0; bj < 2; ++bj)
#pragma unroll
                for (int n = 0; n < 2; ++n) g[bj][n] = *(const f32x4*)(gs + 32 * bj + 8 * fq + 4 * n);
#pragma unroll
            for (int n = 0; n < 2; ++n)
#pragma unroll
                for (int e = 0; e < 4; ++e) invf[n][e] = __builtin_amdgcn_exp2f(-(float)(8 * fq + 4 * n + e) * 0.41524101186092f) * 0.15915494309189535f;
#pragma unroll
            for (int ai = 0; ai < 2; ++ai)
#pragma unroll
                for (int m = 0; m < 4; ++m) {
                    const int row = row0 + ai * HALF + m * 16;
                    const float p = (float)pos[row];
                    float ss = 0.f;
#pragma unroll
                    for (int bj = 0; bj < 2; ++bj)
#pragma unroll
                        for (int n = 0; n < 2; ++n) { const f32x4 v = acc[ai][bj][m][n]; ss += (v[0] * v[0] + v[1] * v[1]) + (v[2] * v[2] + v[3] * v[3]); }
                    ss += __shfl_xor(ss, 16); ss += __shfl_xor(ss, 32);
                    const float rstd = __builtin_amdgcn_rsqf(ss * (1.0f / 64.0f) + 1e-6f) * sc;
                    u32x4 w0, w1;
#pragma unroll
                    for (int n = 0; n < 2; ++n) {
                        const f32x4 y0 = acc[ai][0][m][n] * rstd * g[0][n], y1 = acc[ai][1][m][n] * rstd * g[1][n];
                        f32x4 o0, o1;
#pragma unroll
                        for (int e = 0; e < 4; ++e) {
                            float rev = p * invf[n][e]; rev = __builtin_amdgcn_fractf(rev);
                            const float c = __builtin_amdgcn_cosf(rev), s = __builtin_amdgcn_sinf(rev);
                            o0[e] = y0[e] * c - y1[e] * s; o1[e] = y1[e] * c + y0[e] * s;
                        }
                        w0[2 * n] = cvt_pk_bf16(o0[0], o0[1]); w0[2 * n + 1] = cvt_pk_bf16(o0[2], o0[3]);
                        w1[2 * n] = cvt_pk_bf16(o1[0], o1[1]); w1[2 * n + 1] = cvt_pk_bf16(o1[2], o1[3]);
                    }
                    const int b = row >> 13, s = row & 8191;
                    bf16_t* rp = dst + ((size_t)((b * 8 + head) * 8192 + s)) * 64 + 8 * fq;
                    *(u32x4*)rp = w0; *(u32x4*)(rp + 32) = w1;
                }
        } else {
            const int sec = (pn - 4) >> 1;
            const bool is_none = sec == 0, is_gelu = (sec == 2) || (sec == 3);
            const int cbase = ((pn - 4) & 1) * 256 + wc * 32 + 8 * fq;
            bf16_t* base = sec == 1 ? GB : sec == 2 ? U : sec == 3 ? VA : GA;
#pragma unroll
            for (int ai = 0; ai < 2; ++ai)
#pragma unroll
                for (int m = 0; m < 4; ++m) {
                    const int row = row0 + ai * HALF + m * 16;
#pragma unroll
                    for (int bj = 0; bj < 2; ++bj) {
                        u32x4 w;
#pragma unroll
                        for (int n = 0; n < 2; ++n) {
                            f32x4 v = acc[ai][bj][m][n];
#pragma unroll
                            for (int e = 0; e < 4; ++e) { const float x = v[e]; const float a = is_gelu ? x * (1.5957691216f + 0.0713548163f * x * x) : x; const float y = x * sigmoid_f(a); v[e] = is_none ? x : y; }
                            w[2 * n] = cvt_pk_bf16(v[0], v[1]); w[2 * n + 1] = cvt_pk_bf16(v[2], v[3]);
                        }
                        const int col = cbase + bj * HALF;
                        if (sec == 0) { const int b = row >> 13, s = row & 8191, head = col >> 6, d = col & 63; *(u32x4*)(V + ((size_t)((b * 8 + head) * 8192 + s)) * 64 + d) = w; }
                        else *(u32x4*)(base + (size_t)row * 512 + col) = w;
                    }
                }
        }
    }
};
struct EpiOut {
    static constexpr bool PERM = false, AFTER_DRAIN = false;
    const float* x; float* hout; bf16_t* hb; float* ss;
    __device__ __forceinline__ void operator()(const f32x4 (&acc)[2][2][4][2], const Unit& u, int wr, int wc, int fr, int fq) const {
        const int row0 = u.pm * BM + wr * 64 + fr, col0 = u.pn * BM + wc * 32 + 4 * fq;
#pragma unroll
        for (int ai = 0; ai < 2; ++ai)
#pragma unroll
            for (int m = 0; m < 4; ++m) {
                const int row = row0 + ai * HALF + m * 16; float q = 0.f;
#pragma unroll
                for (int bj = 0; bj < 2; ++bj)
#pragma unroll
                    for (int n = 0; n < 2; ++n) {
                        const size_t off = (size_t)row * 1024 + col0 + bj * HALF + n * 16;
                        const f32x4 h = *(const f32x4*)(x + off) + acc[ai][bj][m][n];
                        *(f32x4*)(hout + off) = h;
                        q += (h[0] * h[0] + h[1] * h[1]) + (h[2] * h[2] + h[3] * h[3]);
                        u32x2 w; w.x = cvt_pk_bf16(h[0], h[1]); w.y = cvt_pk_bf16(h[2], h[3]);
                        *(u32x2*)(hb + off) = w;
                    }
                q += __shfl_xor(q, 16); q += __shfl_xor(q, 32);
                if (fq == 0) atomicAdd(ss + row, q);
            }
    }
};
struct EpiFinal {
    static constexpr bool PERM = false, AFTER_DRAIN = false;
    const float* hin; float* out; const bf16_t* proj; const float* ss; const float* bg;
    __device__ __forceinline__ void operator()(const f32x4 (&acc)[2][2][4][2], const Unit& u, int wr, int wc, int fr, int fq) const {
        const int row0 = u.pm * BM + wr * 64 + fr, col0 = u.pn * BM + wc * 32 + 4 * fq;
        f32x4 bv[2][2];
#pragma unroll
        for (int bj = 0; bj < 2; ++bj)
#pragma unroll
            for (int n = 0; n < 2; ++n) bv[bj][n] = *(const f32x4*)(bg + col0 + bj * HALF + n * 16);
#pragma unroll
        for (int ai = 0; ai < 2; ++ai)
#pragma unroll
            for (int m = 0; m < 4; ++m) {
                const int row = row0 + ai * HALF + m * 16;
                const float rstd = __builtin_amdgcn_rsqf(ss[row] * (1.0f / 1024.0f) + 1e-6f);
#pragma unroll
                for (int bj = 0; bj < 2; ++bj)
#pragma unroll
                    for (int n = 0; n < 2; ++n) {
                        const size_t off = (size_t)row * 1024 + col0 + bj * HALF + n * 16;
                        const f32x4 a = acc[ai][bj][m][n] * rstd + bv[bj][n];
                        const f32x4 hv = *(const f32x4*)(hin + off);
                        const u32x2 pw = *(const u32x2*)(proj + off);
                        f32x4 o;
                        o[0] = hv[0] + sigmoid_f(a[0]) * __uint_as_float(pw.x << 16);
                        o[1] = hv[1] + sigmoid_f(a[1]) * __uint_as_float(pw.x & 0xffff0000u);
                        o[2] = hv[2] + sigmoid_f(a[2]) * __uint_as_float(pw.y << 16);
                        o[3] = hv[3] + sigmoid_f(a[3]) * __uint_as_float(pw.y & 0xffff0000u);
                        *(f32x4*)(out + off) = o;
                    }
            }
    }
};
}
#define GAS __attribute__((address_space(1)))
#define LAS __attribute__((address_space(3)))
typedef unsigned short bf16;
typedef unsigned v4u __attribute__((ext_vector_type(4)));
typedef float f32x4 __attribute__((ext_vector_type(4)));
typedef short bf16x8 __attribute__((ext_vector_type(8)));
typedef GAS unsigned gu32;
typedef GAS unsigned long long gu64;
#define RLX_AGENT __ATOMIC_RELAXED, __HIP_MEMORY_SCOPE_AGENT
#define LDS_WAIT() asm volatile("s_waitcnt lgkmcnt(0)" ::: "memory")
#define VM_WAIT() asm volatile("s_waitcnt vmcnt(0)" ::: "memory")
__device__ __forceinline__ unsigned long long rt() { return __builtin_amdgcn_s_memrealtime(); }
__device__ __forceinline__ unsigned f2bf(float f) { unsigned u = __builtin_bit_cast(unsigned, f); return (u + 0x7fffu + ((u >> 16) & 1u)) >> 16; }
__device__ __forceinline__ unsigned pk2(float lo, float hi) { return f2bf(lo) | (f2bf(hi) << 16); }

#define XB_TMO      128
#define XB_XCNT(j)  (256  + 64 * (j))
#define XB_XSUB(j)  (1280 + 64 * (j))
#define XB_XGEN(j)  (2304 + 64 * (j))
#define XB_TOP      3328
#define XB_TOPGEN   3392
#define XCD_BAR_WORDS 3456
#define XB_SPIN_CAP (1u << 18)

__device__ __forceinline__ unsigned xb_ld(unsigned* p)              { return __hip_atomic_load(p, __ATOMIC_RELAXED, __HIP_MEMORY_SCOPE_AGENT); }
__device__ __forceinline__ unsigned xb_add(unsigned* p, unsigned v) { return __hip_atomic_fetch_add(p, v, __ATOMIC_RELAXED, __HIP_MEMORY_SCOPE_AGENT); }
__device__ __forceinline__ unsigned xb_xcc_id() { return (unsigned)__builtin_amdgcn_s_getreg((3 << 11) | 20) & 0xFu; }
#define XB_SPIN(cond, bar) do { unsigned _sp = 0; while (cond) { __builtin_amdgcn_s_sleep(1); \
    if ((++_sp & 255u) == 0u) { if (xb_ld(&(bar)[XB_TMO])) break; if (_sp > XB_SPIN_CAP) { atomicAdd(&(bar)[XB_TMO], 1u); break; } } } } while (0)

struct XcdBarrier {
    unsigned* bar; unsigned x;
    volatile LAS unsigned* st;
};

__device__ __forceinline__ XcdBarrier xcd_barrier_post(unsigned* bar, volatile LAS unsigned* st) {
    XcdBarrier b; b.bar = bar; b.x = xb_xcc_id(); b.st = st;
    if (threadIdx.x == 0) (void)xb_add(&bar[XB_XCNT(b.x)], 1u);
    return b;
}
__device__ __forceinline__ void xcd_barrier_complete(unsigned* bar, unsigned x, unsigned& nloc, unsigned& nx) {
    const unsigned G = gridDim.x * gridDim.y * gridDim.z;
    unsigned sum, cnt, mine, sp = 0u;
    for (;;) {
        sum = 0u; cnt = 0u; mine = 0u;
#pragma unroll
        for (unsigned j = 0; j < 16; ++j) { const unsigned c = xb_ld(&bar[XB_XCNT(j)]); sum += c; cnt += (c > 0u) ? 1u : 0u; mine = (j == x) ? c : mine; }
        if (sum == G) break;
        __builtin_amdgcn_s_sleep(1);
        if ((++sp & 255u) == 0u) { if (xb_ld(&bar[XB_TMO])) break; if (sp > XB_SPIN_CAP) { atomicAdd(&bar[XB_TMO], 1u); break; } }
    }
    nloc = mine > 0u ? mine : 1u; nx = cnt > 0u ? cnt : 1u;
}

__device__ __forceinline__ void xcd_barrier(const XcdBarrier& b) {
    asm volatile("s_waitcnt vmcnt(0)" ::: "memory");
    __syncthreads();
    if (threadIdx.x == 0) {
        unsigned* bar = b.bar;
        __builtin_amdgcn_s_waitcnt(0);
        unsigned nloc = b.st[0], nx = b.st[1];
        if (nloc == 0u) { xcd_barrier_complete(bar, b.x, nloc, nx); b.st[0] = nloc; b.st[1] = nx; }
        const unsigned old = xb_add(&bar[XB_XSUB(b.x)], 1u);
        const unsigned gen = old / nloc;
        if (old + 1u == (gen + 1u) * nloc) {
            __builtin_amdgcn_fence(__ATOMIC_RELEASE, "agent");
            asm volatile("s_waitcnt vmcnt(0)" ::: "memory");
            const unsigned og = xb_add(&bar[XB_TOP], 1u);
            const unsigned tg = og / nx;
            if (og + 1u == (tg + 1u) * nx) xb_add(&bar[XB_TOPGEN], 1u);
            else XB_SPIN(xb_ld(&bar[XB_TOPGEN]) == tg, bar);
            __builtin_amdgcn_fence(__ATOMIC_ACQUIRE, "agent");
            xb_add(&bar[XB_XGEN(b.x)], 1u);
            asm volatile("s_waitcnt vmcnt(0)" ::: "memory");
        } else {
            XB_SPIN(xb_ld(&bar[XB_XGEN(b.x)]) == gen, bar);
            __builtin_amdgcn_fence(__ATOMIC_ACQUIRE, "agent");
            asm volatile("s_waitcnt vmcnt(0)" ::: "memory");
        }
    }
    __syncthreads();
}
constexpr int NWAVES = 8;
#ifndef MK_N_LAUNCHES
#define MK_N_LAUNCHES 1
#endif
constexpr int PER_PHASE = 6;
constexpr int N_LAUNCHES = MK_N_LAUNCHES;
static_assert(N_LAUNCHES == 1 || N_LAUNCHES == PER_PHASE, "MK_N_LAUNCHES is 1 or 6");

constexpr int BATCH = 4, SEQ = 8192, DM = 1024, NH = 8, HD = 64, AW = 512, GW = 512, INC = 3584, PLE = 256;
constexpr int M = BATCH * SEQ;
constexpr float EPS = 1e-6f;

constexpr size_t MiB = 1u << 20;
constexpr size_t WS_CTL = 0, CTL_ZERO_BYTES = 1 * MiB;
constexpr size_t WS_WIN = 2 * MiB;
constexpr size_t WS_WOUT = 10 * MiB;
constexpr size_t WS_WG = 12 * MiB;
constexpr size_t WS_WP = 14 * MiB;
constexpr size_t WS_WSP = 15 * MiB;
constexpr size_t WS_SS = 512 * 1024;
constexpr size_t WS_DEN4 = 16 * MiB, WS_DEN16 = 17 * MiB;
constexpr size_t WS_PB = 18 * MiB;
constexpr size_t WS_A = 34 * MiB;
constexpr size_t WS_MIXED = WS_A;
constexpr size_t WS_Q = 98 * MiB, WS_K = 130 * MiB, WS_V = 162 * MiB;
constexpr size_t WS_HB = WS_Q;
constexpr size_t WS_GB = 194 * MiB, WS_U = 226 * MiB, WS_VA = 258 * MiB, WS_GA = 290 * MiB;
constexpr size_t WS_PROJ = WS_GB;
constexpr size_t WS_P4 = 322 * MiB, WS_P16 = 354 * MiB;
constexpr size_t WS_END = 386 * MiB;
constexpr int CW_BAR = 4096;

constexpr int RING_OFF = 0, RING_BYTES = 139264;
constexpr int LDSCTL_OFF = RING_BYTES, MISC_OFF = LDSCTL_OFF + 320;
constexpr int LDS_BYTES = 147456;
static_assert(MISC_OFF + 128 <= LDS_BYTES, "LDS map");

__device__ __forceinline__ float wave_sum(float v) {
#pragma unroll
    for (int o = 1; o < 64; o <<= 1) v += __shfl_xor(v, o);
    return v;
}
__device__ __forceinline__ float wave_max(float v) {
#pragma unroll
    for (int o = 1; o < 64; o <<= 1) v = fmaxf(v, __shfl_xor(v, o));
    return v;
}
__device__ __forceinline__ float bflo(unsigned w) { return __uint_as_float(w << 16); }
__device__ __forceinline__ float bfhi(unsigned w) { return __uint_as_float(w & 0xffff0000u); }
template <bool QKPERM> __device__ __forceinline__ void p0_transpose_item(const float* W, int K, int N, bf16* WT, const float* kscale, LAS float* scr, int item, int lane) {
    const int nblk = N / 32, kb = item / nblk, nb = item % nblk, k0 = 64 * kb, n0 = 32 * nb;
#pragma unroll 8
    for (int i = 0; i < 32; ++i) { const int kk = 2 * i + (lane >> 5); float v = W[(size_t)(k0 + kk) * N + n0 + (lane & 31)]; if (kscale) v *= kscale[k0 + kk]; scr[kk * 33 + (lane & 31)] = v; }
    LDS_WAIT(); asm volatile("" ::: "memory");
    int r0 = n0;
    if (QKPERM && n0 < 1024) { const int pn = n0 >> 8, w = n0 & 255; r0 = pn * 256 + ((w >> 5) & 1) * 128 + (w >> 6) * 32; }
    const int c = lane & 7;
#pragma unroll
    for (int j = 0; j < 4; ++j) { const int n = (lane >> 3) + 8 * j; const LAS float* s = scr + (8 * c) * 33 + n;
        v4u o; o.x = pk2(s[0 * 33], s[1 * 33]); o.y = pk2(s[2 * 33], s[3 * 33]); o.z = pk2(s[4 * 33], s[5 * 33]); o.w = pk2(s[6 * 33], s[7 * 33]);
        *(GAS v4u*)(WT + (size_t)(r0 + n) * K + k0 + 8 * c) = o; }
    LDS_WAIT(); asm volatile("" ::: "memory");
}

namespace att {
typedef short bf16x8 __attribute__((ext_vector_type(8)));
typedef short v4i16 __attribute__((ext_vector_type(4)));
typedef float f32x16 __attribute__((ext_vector_type(16)));
typedef unsigned u32x4 __attribute__((ext_vector_type(4)));
typedef unsigned u32x2 __attribute__((ext_vector_type(2)));
constexpr int KOFF = 0, VOFF = 384 * 128, STG = 2 * 384 * 128, STG_ROW = 144, STG_W = 32 * STG_ROW, DSC = STG + 8 * STG_W, ATT_LDS = DSC + 8 * 32 * 4;
static_assert(ATT_LDS <= RING_BYTES, "attention LDS");
__device__ __forceinline__ int crow(int r, int hi) { return (r & 3) + 8 * (r >> 2) + 4 * hi; }
typedef float f32x2_t __attribute__((ext_vector_type(2))); typedef __bf16 bf16x2_t __attribute__((ext_vector_type(2)));
__device__ __forceinline__ unsigned cvtpk(float lo, float hi) { f32x2_t v = {lo, hi}; bf16x2_t b = __builtin_convertvector(v, bf16x2_t); return __builtin_bit_cast(unsigned, b); }
struct Tens { const bf16 *Q, *K, *V; bf16 *P4, *P16; float *D4, *D16; const bf16* GB; bf16* MIXED; };
struct Unit { int R, b, h, res, blk; };
struct Pre { u32x4 kv[6], vv[6]; bf16x8 qf[4]; };

__device__ __forceinline__ void unit_load(Pre& P, const Tens& T, const Unit& u, int tid, int wid, int r32, int hi) {
    const size_t hb = (size_t)(u.b * NH + u.h) * SEQ * HD;
    const int l0 = u.blk * 256, ch = tid & 7;
#pragma unroll
    for (int i = 0; i < 6; ++i) {
        const int row = (tid >> 3) + 64 * i, l = l0 - 128 + row;
        if (l >= 0) { const size_t off = hb + (size_t)(l * u.R + u.res) * HD + ch * 8; P.kv[i] = *(const GAS u32x4*)(T.K + off); P.vv[i] = *(const GAS u32x4*)(T.V + off); }
        else { P.kv[i] = (u32x4){0u, 0u, 0u, 0u}; P.vv[i] = (u32x4){0u, 0u, 0u, 0u}; }
    }
    const size_t qoff = hb + (size_t)((l0 + 32 * wid + r32) * u.R + u.res) * HD + 8 * hi;
#pragma unroll
    for (int ks = 0; ks < 4; ++ks) P.qf[ks] = *(const GAS bf16x8*)(T.Q + qoff + 16 * ks);
}
__device__ __forceinline__ void unit_stage(const Pre& P, LAS unsigned char* lds, int tid) {
    const int ch = tid & 7;
#pragma unroll
    for (int i = 0; i < 6; ++i) {
        const int row = (tid >> 3) + 64 * i;
        *(LAS u32x4*)(lds + KOFF + row * 128 + ((ch ^ ((row >> 1) & 7)) << 4)) = P.kv[i];
        *(LAS u32x4*)(lds + VOFF + row * 128 + ((ch ^ (((row >> 1) & 1) << 2)) << 4)) = P.vv[i];
    }
}
template <bool MERGE> __device__ __forceinline__ void unit_compute(const bf16x8 (&qf)[4], LAS unsigned char* lds, const Tens& T, const Unit& u, float negM, int lane, int wid, int r32, int hi) {
    f32x16 oT[2]; float dsum = 0.f;
#pragma unroll
    for (int r = 0; r < 16; ++r) { oT[0][r] = 0.f; oT[1][r] = 0.f; }
    const int q4 = (lane & 15) >> 2, p4 = lane & 3, g1 = (lane >> 4) & 1;
#pragma unroll
    for (int j = 0; j < 5; ++j) {
        if (u.blk == 0 && wid + j < 4) continue;
        const int rb = 32 * (wid + j), krow = rb + r32, ksw = (krow >> 1) & 7;
        const LAS unsigned char* kp = lds + KOFF + krow * 128;
        f32x16 p;
#pragma unroll
        for (int r = 0; r < 16; ++r) p[r] = negM;
#pragma unroll
        for (int ks = 0; ks < 4; ++ks) { const bf16x8 kf = *(const LAS bf16x8*)(kp + (((2 * ks + hi) ^ ksw) << 4)); p = __builtin_amdgcn_mfma_f32_32x32x16_bf16(kf, qf[ks], p, 0, 0, 0); }
        if (j == 0) {
#pragma unroll
            for (int r = 0; r < 16; ++r) if (crow(r, hi) < r32) p[r] = -INFINITY;
        }
        if (j == 4) {
#pragma unroll
            for (int r = 0; r < 16; ++r) if (crow(r, hi) > r32) p[r] = -INFINITY;
        }
#pragma unroll
        for (int r = 0; r < 16; ++r) { p[r] = __builtin_amdgcn_exp2f(p[r]); dsum += p[r]; }
        bf16x8 pa[2];
#pragma unroll
        for (int s = 0; s < 2; ++s) { u32x4 w; w.x = cvtpk(p[8 * s + 0], p[8 * s + 1]); w.y = cvtpk(p[8 * s + 2], p[8 * s + 3]); w.z = cvtpk(p[8 * s + 4], p[8 * s + 5]); w.w = cvtpk(p[8 * s + 6], p[8 * s + 7]); pa[s] = __builtin_bit_cast(bf16x8, w); }
#pragma unroll
        for (int s = 0; s < 2; ++s)
#pragma unroll
            for (int db = 0; db < 2; ++db) {
                const int vrow = rb + 16 * s + 4 * hi + q4, chn = 4 * db + 2 * g1 + (p4 >> 1);
                const LAS unsigned char* vp = lds + VOFF + vrow * 128 + ((chn ^ (((vrow >> 1) & 1) << 2)) << 4) + 8 * (p4 & 1);
                const v4i16 lo = __builtin_amdgcn_ds_read_tr16_b64_v4i16((LAS v4i16*)vp);
                const v4i16 hh = __builtin_amdgcn_ds_read_tr16_b64_v4i16((LAS v4i16*)(vp + 1024));
                const bf16x8 vf = (bf16x8){lo[0], lo[1], lo[2], lo[3], hh[0], hh[1], hh[2], hh[3]};
                oT[db] = __builtin_amdgcn_mfma_f32_32x32x16_bf16(vf, pa[s], oT[db], 0, 0, 0);
            }
    }
    const float dtot = dsum + __shfl_xor(dsum, 32);
    LAS unsigned char* stg = lds + STG + wid * STG_W;
    LAS float* dsc = (LAS float*)(lds + DSC) + wid * 32;
#pragma unroll
    for (int db = 0; db < 2; ++db)
#pragma unroll
        for (int r4 = 0; r4 < 4; ++r4) { u32x2 w; w.x = cvtpk(oT[db][4 * r4 + 0], oT[db][4 * r4 + 1]); w.y = cvtpk(oT[db][4 * r4 + 2], oT[db][4 * r4 + 3]);
            *(LAS u32x2*)(stg + r32 * STG_ROW + (32 * db + 8 * r4 + 4 * hi) * 2) = w; }
    const int l0 = u.blk * 256;
    const size_t growq = (size_t)u.b * SEQ + (size_t)((l0 + 32 * wid + r32) * u.R + u.res);
    if (MERGE) { if (hi == 0) dsc[r32] = dtot; }
    else { if (hi == 0) { float* D = (u.R == 4) ? T.D4 : T.D16; D[growq * NH + u.h] = dtot; } }
    asm volatile("s_waitcnt lgkmcnt(0)" ::: "memory");
#pragma unroll
    for (int i = 0; i < 4; ++i) {
        const int row = (lane >> 3) + 8 * i, ch = lane & 7;
        const u32x4 v = *(const LAS u32x4*)(stg + row * STG_ROW + ch * 16);
        const size_t grow = (size_t)u.b * SEQ + (size_t)((l0 + 32 * wid + row) * u.R + u.res);
        const size_t poff = grow * AW + u.h * HD + ch * 8;
        if (!MERGE) { bf16* Pd = (u.R == 4) ? T.P4 : T.P16; *(GAS u32x4*)(Pd + poff) = v; }
        else {
            const u32x4 a = *(const GAS u32x4*)(T.P4 + poff), c = *(const GAS u32x4*)(T.P16 + poff), g = *(const GAS u32x4*)(T.GB + poff);
            const float d = dsc[row] + T.D4[grow * NH + u.h] + T.D16[grow * NH + u.h];
            const float inv = 1.0f / d;
            u32x4 o;
#pragma unroll
            for (int e = 0; e < 4; ++e) {
                const float x0 = (bflo(v[e]) + bflo(a[e]) + bflo(c[e])) * inv * bflo(g[e]);
                const float x1 = (bfhi(v[e]) + bfhi(a[e]) + bfhi(c[e])) * inv * bfhi(g[e]);
                o[e] = cvtpk(x0, x1);
            }
            *(GAS u32x4*)(T.MIXED + grow * DM + u.h * HD + ch * 8) = o;
        }
    }
}
__device__ __forceinline__ Unit unit_of(int idx, bool merge) {
    Unit u;
    if (merge) { u.R = 1; const int bh = idx >> 5; u.b = bh >> 3; u.h = bh & 7; u.res = 0; u.blk = idx & 31; }
    else { const int br = idx >> 10, w = idx & 1023, bh = w >> 5, rb = w & 31; u.b = bh >> 3; u.h = bh & 7;
        if (br == 0) { u.R = 16; u.res = rb >> 1; u.blk = rb & 1; } else { u.R = 4; u.res = rb >> 3; u.blk = rb & 7; } }
    return u;
}
template <bool MERGE> __device__ __forceinline__ void attn_phase(LAS unsigned char* lds, const Tens& T, int vcu, int G, const float* qn, const float* kn) {
    const int tid = threadIdx.x, lane = tid & 63, r32 = lane & 31, hi = lane >> 5, wid = __builtin_amdgcn_readfirstlane(tid >> 6);
    const int total = MERGE ? 1024 : 2048;
    const float mq = wave_max(fabsf(qn[lane])), mk = wave_max(fabsf(kn[lane]));
    const float negM = -8.0f * mq * mk * 1.4426950408889634f;
    Pre P;
    int idx = vcu;
    if (idx < total) { const Unit u = unit_of(idx, MERGE); unit_load(P, T, u, tid, wid, r32, hi); }
    for (; idx < total; idx += G) {
        const Unit u = unit_of(idx, MERGE);
        unit_stage(P, lds, tid);
        bf16x8 qf[4];
#pragma unroll
        for (int ks = 0; ks < 4; ++ks) qf[ks] = P.qf[ks];
        __syncthreads();
        if (idx + G < total) { const Unit un = unit_of(idx + G, MERGE); unit_load(P, T, un, tid, wid, r32, hi); }
        unit_compute<MERGE>(qf, lds, T, u, negM, lane, wid, r32, hi);
        __syncthreads();
    }
}
}

namespace gm {
typedef short bf16x8 __attribute__((ext_vector_type(8)));
typedef short v4i16 __attribute__((ext_vector_type(4)));
typedef float f32x16 __attribute__((ext_vector_type(16)));
typedef unsigned u32x4 __attribute__((ext_vector_type(4)));
__device__ __forceinline__ int crow(int r, int hi) { return (r & 3) + 8 * (r >> 2) + 4 * hi; }
__device__ __forceinline__ void gmlp_unit(LAS unsigned char* lds, int uc, const bf16* VA, const bf16* U, const bf16* GA, const bf16* WSb, const float* bs, const float* lng, const float* lnb, bf16* MIXED) {
    const int tid = threadIdx.x, lane = tid & 63, r32 = lane & 31, hi = lane >> 5, wid = __builtin_amdgcn_readfirstlane(tid >> 6);
    const size_t T0 = (size_t)uc * 128;
    float lg[8], lb[8];
#pragma unroll
    for (int e = 0; e < 8; ++e) { lg[e] = lng[lane * 8 + e]; lb[e] = lnb[lane * 8 + e]; }
#pragma unroll 4
    for (int rr = 0; rr < 16; ++rr) {
        const int row = 16 * wid + rr;
        const u32x4 w = *(const GAS u32x4*)(VA + (T0 + row) * GW + lane * 8);
        float v[8];
#pragma unroll
        for (int e = 0; e < 4; ++e) { v[2 * e] = bflo(w[e]); v[2 * e + 1] = bfhi(w[e]); }
        float s = 0.f;
#pragma unroll
        for (int e = 0; e < 8; ++e) s += v[e];
        const float mean = wave_sum(s) * (1.0f / 512.0f);
        float q = 0.f;
#pragma unroll
        for (int e = 0; e < 8; ++e) { v[e] -= mean; q += v[e] * v[e]; }
        const float rstd = 1.0f / sqrtf(wave_sum(q) * (1.0f / 512.0f) + EPS);
        u32x4 o;
#pragma unroll
        for (int e = 0; e < 4; ++e) o[e] = pk2(v[2 * e] * rstd * lg[2 * e] + lb[2 * e], v[2 * e + 1] * rstd * lg[2 * e + 1] + lb[2 * e + 1]);
        *(LAS u32x4*)(lds + (lane >> 3) * 16384 + row * 128 + (((lane & 7) ^ (((row >> 1) & 1) << 2)) << 4)) = o;
    }
    __syncthreads();
    const int g = wid >> 1;
    const bf16* Wg = WSb + (size_t)g * 128 * 128;
    const LAS unsigned char* img = lds + wid * 16384;
    const int q4 = (lane & 15) >> 2, p4 = lane & 3, g1 = (lane >> 4) & 1;
#pragma unroll 1
    for (int tt = 0; tt < 4; ++tt) {
        f32x16 acc[2];
#pragma unroll
        for (int r = 0; r < 16; ++r) { acc[0][r] = 0.f; acc[1][r] = 0.f; }
        const int nks = 2 * tt + 2;
        for (int ks = 0; ks < nks; ++ks) {
            const bf16x8 a = *(const GAS bf16x8*)(Wg + (size_t)(32 * tt + r32) * 128 + 16 * ks + 8 * hi);
#pragma unroll
            for (int dt = 0; dt < 2; ++dt) {
                const int vrow = 16 * ks + 8 * hi + q4, chn = 4 * dt + 2 * g1 + (p4 >> 1);
                const LAS unsigned char* vp = img + vrow * 128 + ((chn ^ (((vrow >> 1) & 1) << 2)) << 4) + 8 * (p4 & 1);
                const v4i16 lo = __builtin_amdgcn_ds_read_tr16_b64_v4i16((LAS v4i16*)vp);
                const v4i16 hh = __builtin_amdgcn_ds_read_tr16_b64_v4i16((LAS v4i16*)(vp + 512));
                const bf16x8 vf = (bf16x8){lo[0], lo[1], lo[2], lo[3], hh[0], hh[1], hh[2], hh[3]};
                acc[dt] = __builtin_amdgcn_mfma_f32_32x32x16_bf16(a, vf, acc[dt], 0, 0, 0);
            }
        }
#pragma unroll
        for (int r = 0; r < 16; ++r) {
            const int t = 32 * tt + crow(r, hi);
            const float bias = bs[g * 128 + t];
#pragma unroll
            for (int dt = 0; dt < 2; ++dt) {
                const int col = 64 * wid + 32 * dt + r32;
                const size_t off = (T0 + t) * GW + col;
                const float uu = __uint_as_float((unsigned)U[off] << 16), ga = __uint_as_float((unsigned)GA[off] << 16);
                MIXED[(T0 + t) * DM + AW + col] = (bf16)f2bf(uu * (acc[dt][r] + bias) * ga);
            }
        }
    }
    __syncthreads();
}
}

struct Args { const void* in[16]; float* out; unsigned char* ws; int ph_lo, ph_hi, li, pad; };
__global__ void __launch_bounds__(NWAVES * 64, 2) mk_fwd(Args args) {
    extern __shared__ __attribute__((aligned(16))) unsigned char lds_raw[];
    LAS unsigned char* lds = (LAS unsigned char*)lds_raw;
    volatile LAS unsigned* MISC = (volatile LAS unsigned*)(lds + MISC_OFF);
    const int tid = threadIdx.x, lane = tid & 63, wave = __builtin_amdgcn_readfirstlane(tid >> 6);
    const int G = gridDim.x, bx = blockIdx.x, vcu = (G % 8 == 0) ? (bx % 8) * (G / 8) + bx / 8 : bx;
    unsigned char* ws = args.ws;
    gu32* ctl = (gu32*)(ws + WS_CTL);
    const float* x = (const float*)args.in[0]; const float* pin = (const float*)args.in[1]; const int* pos = (const int*)args.in[2];
    const float* g_in = (const float*)args.in[3]; const float* w_in = (const float*)args.in[4]; const float* qn = (const float*)args.in[5]; const float* kn = (const float*)args.in[6];
    const float* w_sp = (const float*)args.in[7]; const float* b_sp = (const float*)args.in[8]; const float* lng = (const float*)args.in[9]; const float* lnb = (const float*)args.in[10];
    const float* w_out = (const float*)args.in[11]; const float* g_ple = (const float*)args.in[12]; const float* w_g = (const float*)args.in[13]; const float* b_g = (const float*)args.in[14]; const float* w_p = (const float*)args.in[15];
    float* out = args.out;
    bf16 *Win_t = (bf16*)(ws + WS_WIN), *Wout_t = (bf16*)(ws + WS_WOUT), *Wg_t = (bf16*)(ws + WS_WG), *Wp_t = (bf16*)(ws + WS_WP), *WSb = (bf16*)(ws + WS_WSP);
    float* SS = (float*)(ws + WS_SS); float* DEN4 = (float*)(ws + WS_DEN4); float* DEN16 = (float*)(ws + WS_DEN16);
    bf16 *PB = (bf16*)(ws + WS_PB), *A = (bf16*)(ws + WS_A), *MIXED = (bf16*)(ws + WS_MIXED), *QB = (bf16*)(ws + WS_Q), *KB = (bf16*)(ws + WS_K), *VB = (bf16*)(ws + WS_V), *HB = (bf16*)(ws + WS_HB);
    bf16 *GB = (bf16*)(ws + WS_GB), *UB = (bf16*)(ws + WS_U), *VA = (bf16*)(ws + WS_VA), *GA = (bf16*)(ws + WS_GA), *PROJ = (bf16*)(ws + WS_PROJ), *P4 = (bf16*)(ws + WS_P4), *P16 = (bf16*)(ws + WS_P16);

    for (int u = tid; u < (LDS_BYTES - LDSCTL_OFF) / 4; u += NWAVES * 64) ((LAS unsigned*)(lds + LDSCTL_OFF))[u] = 0u;
    __syncthreads();
    XcdBarrier bar; bar.bar = (unsigned*)(ctl + CW_BAR); bar.x = 0; bar.st = nullptr;
    if (N_LAUNCHES == 1) bar = xcd_barrier_post((unsigned*)(ctl + CW_BAR), MISC + 8);
#define GRID_BAR() do { if (N_LAUNCHES == 1) xcd_barrier(bar); } while (0)
    const int lo = args.ph_lo, hi_ph = args.ph_hi;
#define IN(k) (lo <= (k) && (k) < hi_ph)

    if (IN(0)) {
        LAS float* scr = (LAS float*)(lds + RING_OFF + wave * 16384);
        const int gw = vcu * NWAVES + wave, NGW = G * NWAVES;
        constexpr int I_IN = (DM / 64) * (INC / 32), I_OUT = (DM / 64) * (DM / 32), I_G = I_OUT, I_P = (PLE / 64) * (DM / 32);
        constexpr int NITEMS = I_IN + I_OUT + I_G + I_P;
        for (int it = gw; it < NITEMS; it += NGW) {
            int r = it;
            if (r < I_IN) { p0_transpose_item<true>(w_in, DM, INC, Win_t, nullptr, scr, r, lane); continue; } r -= I_IN;
            if (r < I_OUT) { p0_transpose_item<false>(w_out, DM, DM, Wout_t, nullptr, scr, r, lane); continue; } r -= I_OUT;
            if (r < I_G) { p0_transpose_item<false>(w_g, DM, DM, Wg_t, g_ple, scr, r, lane); continue; } r -= I_G;
            p0_transpose_item<false>(w_p, PLE, DM, Wp_t, nullptr, scr, r, lane);
        }
        const int gt = vcu * NWAVES * 64 + tid, NGT = G * NWAVES * 64;
        for (int i = gt; i < 4 * 128 * 128; i += NGT) { const int s = i & 127, t = (i >> 7) & 127; WSb[i] = (bf16)f2bf(s <= t ? w_sp[i] : 0.0f); }
        f32x4 gv[4];
#pragma unroll
        for (int j = 0; j < 4; ++j) gv[j] = *((const GAS f32x4*)g_in + lane + 64 * j);
        for (int m = gw; m < M; m += NGW) {
            const GAS f32x4* xr = (const GAS f32x4*)(x + (size_t)m * DM) + lane;
            f32x4 v[4]; float s2 = 0.f;
#pragma unroll
            for (int j = 0; j < 4; ++j) { v[j] = xr[64 * j]; s2 += (v[j].x * v[j].x + v[j].y * v[j].y) + (v[j].z * v[j].z + v[j].w * v[j].w); }
            const float rstd = 1.0f / sqrtf(wave_sum(s2) * (1.0f / DM) + EPS);
            GAS unsigned long long* o8 = (GAS unsigned long long*)(A + (size_t)m * DM) + lane;
#pragma unroll
            for (int j = 0; j < 4; ++j) o8[64 * j] = (unsigned long long)pk2(v[j].x * rstd * gv[j].x, v[j].y * rstd * gv[j].y) | ((unsigned long long)pk2(v[j].z * rstd * gv[j].z, v[j].w * rstd * gv[j].w) << 32);
            const f32x4 pv = *((const GAS f32x4*)(pin + (size_t)m * PLE) + lane);
            *((GAS unsigned long long*)(PB + (size_t)m * PLE) + lane) = (unsigned long long)pk2(pv.x, pv.y) | ((unsigned long long)pk2(pv.z, pv.w) << 32);
        }
        if (IN(1)) GRID_BAR();
    }
    if (IN(1)) {
        pg8::Gemm g{A, Win_t, M, INC, DM}; pg8::StaticOrder S; S.init(M, INC, G, bx);
        pg8::EpiIn E{QB, KB, VB, GB, UB, VA, GA, qn, kn, pos, 0.125f * 1.4426950408889634f};
        pg8::gemm_phase<pg8::EpiIn, pg8::StaticOrder, PG8_ALIGN, PG8_SP2>(lds + RING_OFF, g, S, E);
        if (IN(2)) GRID_BAR();
    }
    att::Tens AT{QB, KB, VB, P4, P16, DEN4, DEN16, GB, MIXED};
    if (IN(2)) {
        att::attn_phase<false>(lds + RING_OFF, AT, vcu, G, qn, kn);
        for (int uc = vcu; uc < M / 128; uc += G) gm::gmlp_unit(lds + RING_OFF, uc, VA, UB, GA, WSb, b_sp, lng, lnb, MIXED);
        if (IN(3)) GRID_BAR();
    }
    if (IN(3)) {
        att::attn_phase<true>(lds + RING_OFF, AT, vcu, G, qn, kn);
        if (IN(4)) GRID_BAR();
    }
    if (IN(4)) {
        { pg8::Gemm g{MIXED, Wout_t, M, DM, DM}; pg8::StaticOrder S; S.init(M, DM, G, bx);
          pg8::EpiOut E{x, out, HB, SS};
          pg8::gemm_phase<pg8::EpiOut, pg8::StaticOrder, PG8_ALIGN, PG8_SP2>(lds + RING_OFF, g, S, E); }
        { pg8::Gemm g{PB, Wp_t, M, DM, PLE}; pg8::StaticOrder S; S.init(M, DM, G, bx);
          pg8::EpiBf16<0> E{PROJ, DM, nullptr, 0, 0, 1.f};
          pg8::gemm_phase<pg8::EpiBf16<0>, pg8::StaticOrder, PG8_ALIGN, PG8_SP2>(lds + RING_OFF, g, S, E); }
        if (IN(5)) GRID_BAR();
    }
    if (IN(5)) {
        pg8::Gemm g{HB, Wg_t, M, DM, DM}; pg8::StaticOrder S; S.init(M, DM, G, bx);
        pg8::EpiFinal E{out, out, PROJ, SS, b_g};
        pg8::gemm_phase<pg8::EpiFinal, pg8::StaticOrder, PG8_ALIGN, PG8_SP2>(lds + RING_OFF, g, S, E);
    }
#undef IN
#undef GRID_BAR
}

extern "C" void kernel_launch(void* const* d_in, const int* in_sizes, int n_in, void* d_out, int out_size, void* d_ws, size_t ws_size, hipStream_t stream) {
    static int grid = 0;
    if (grid == 0) {
        if (n_in != 16 || in_sizes[0] != M * DM || out_size != M * DM || ws_size < WS_END) { fprintf(stderr, "kernel_launch: unexpected shapes (n_in %d, in0 %d, out %d, ws %zu); nothing launched\n", n_in, n_in > 0 ? in_sizes[0] : -1, out_size, ws_size); grid = -1; return; }
        int dev = 0, cus = 0, per_cu = 0;
        if (hipGetDevice(&dev) != hipSuccess || hipDeviceGetAttribute(&cus, hipDeviceAttributeMultiprocessorCount, dev) != hipSuccess) { grid = -1; return; }
        if (hipFuncSetAttribute((const void*)mk_fwd, hipFuncAttributeMaxDynamicSharedMemorySize, LDS_BYTES) != hipSuccess) { fprintf(stderr, "kernel_launch: hipFuncSetAttribute failed\n"); grid = -1; return; }
        if (hipOccupancyMaxActiveBlocksPerMultiprocessor(&per_cu, (const void*)mk_fwd, NWAVES * 64, LDS_BYTES) != hipSuccess || per_cu < 1) fprintf(stderr, "kernel_launch: occupancy query reports %d per CU\n", per_cu);
        (void)hipGetLastError();
        grid = cus;
    }
    if (grid < 0) return;
    if (hipMemsetAsync((char*)d_ws + WS_CTL, 0, CTL_ZERO_BYTES, stream) != hipSuccess) return;
    Args a{};
    for (int i = 0; i < 16; ++i) a.in[i] = d_in[i];
    a.out = (float*)d_out; a.ws = (unsigned char*)d_ws;
    for (int li = 0; li < N_LAUNCHES; ++li) {
        a.ph_lo = (N_LAUNCHES == PER_PHASE) ? li : 0; a.ph_hi = (N_LAUNCHES == PER_PHASE) ? li + 1 : PER_PHASE; a.li = li;
        hipLaunchKernelGGL(mk_fwd, dim3(grid), dim3(NWAVES * 64), LDS_BYTES, stream, a);
        const hipError_t le = hipPeekAtLastError();
        if (le != hipSuccess) { fprintf(stderr, "kernel_launch: launch %d failed: %s\n", li, hipGetErrorName(le)); break; }
    }
}
```

```cpp
#define MK_PLAN 0
#include <hip/hip_runtime.h>
#include <cstdio>
#include <cstdint>
namespace pg8 {
#define PG8_LAS __attribute__((address_space(3)))
typedef unsigned short bf16_t;
typedef short bf16x8 __attribute__((ext_vector_type(8)));
typedef float f32x4 __attribute__((ext_vector_type(4)));
typedef unsigned u32x4 __attribute__((ext_vector_type(4)));
constexpr int BM = 256, BK = 64, HALF = 128, HTB = HALF * BK * 2  , STAGE_BYTES = 8 * HTB, NXCD = 8, WGM = 8;

__host__ __device__ __forceinline__ int lds_byte(int r, int c) { const int st = (r >> 4) * 2 + (c >> 5), rr = r & 15, cc = c & 31, ob = rr * 64 + cc * 2; return st * 1024 + (ob ^ (((ob >> 9) & 1) << 5)); }
__host__ __device__ __forceinline__ void stage_rc(int b, int& R, int& C) { const int st = b / 1024, sb = b % 1024, swz = sb ^ (((sb >> 9) & 1) << 5); R = (st >> 1) * 16 + swz / 64; C = (st & 1) * 32 + (swz % 64) / 2; }
__host__ __device__ __forceinline__ int perm32(int rho) { const int n = rho >> 4, i = rho & 15; return 8 * (i >> 2) + 4 * n + (i & 3); }

struct Unit { int pm, pn; };
struct Gemm { const bf16_t* A; const bf16_t* Bt; int M, N, K; };

struct StaticOrder {
    int nM, nN, nwg, G, c;
    __host__ __device__ void init(int M, int N, int G_, int c_) { nM = M / BM; nN = N / BM; nwg = nM * nN; G = G_; c = c_; }
    __host__ __device__ bool next(int i, Unit& u) const {
        const long L = (long)i * G + c; if (L >= nwg) return false;
        int wgid = (int)L; { const int q = nwg / NXCD, r = nwg % NXCD, xcd = wgid % NXCD, off = wgid / NXCD; wgid = (xcd < r ? xcd * (q + 1) : r * (q + 1) + (xcd - r) * q) + off; }
        const int nig = WGM * nN, gid = wgid / nig, fm = gid * WGM, gsz = (nM - fm) < WGM ? (nM - fm) : WGM;
        u.pm = fm + ((wgid % nig) % gsz); u.pn = (wgid % nig) / gsz; return true;
    }
    __device__ __forceinline__ void a_ready(const Unit&) const {}
    __device__ __forceinline__ void done(const Unit&) const {}
};

typedef float f32x2c_t __attribute__((ext_vector_type(2))); typedef __bf16 bf16x2c_t __attribute__((ext_vector_type(2)));
__device__ __forceinline__ unsigned cvt_pk_bf16(float lo, float hi) { f32x2c_t v = {lo, hi}; bf16x2c_t b = __builtin_convertvector(v, bf16x2c_t); return __builtin_bit_cast(unsigned, b); }
typedef float f32x2 __attribute__((ext_vector_type(2)));
__device__ __forceinline__ f32x2 gelu_pk(f32x2 v) {
    const f32x2 av = __builtin_elementwise_abs(v), d = av * 0.2316418882f + 1.0f;
    f32x2 t; t.x = __builtin_amdgcn_rcpf(d.x); t.y = __builtin_amdgcn_rcpf(d.y);
    f32x2 q = t * 0.5307027145f + (-0.7265760135f); q = q * t + 0.7107068705f; q = q * t + (-0.142248368f); q = q * t + 0.127414796f; q = q * t;
    const f32x2 s = (v * v) * (-0.72134752044f);
    f32x2 e; e.x = __builtin_amdgcn_exp2f(s.x); e.y = __builtin_amdgcn_exp2f(s.y);
    const f32x2 m = v * (q * e), r = v - m;
    f32x2 o; o.x = v.x < 0.f ? m.x : r.x; o.y = v.y < 0.f ? m.y : r.y; return o;
}

template <int ACT  > struct EpiBf16 {
    static constexpr bool PERM = true, AFTER_DRAIN = false; static_assert(ACT == 0 || ACT == 1, "EpiBf16: ACT is 0 (none) or 1 (gelu_pk)");
    bf16_t* O; int ldc; const float* bias; int split_cols; size_t split_stride; float scale0;
    __device__ __forceinline__ void operator()(const f32x4 (&acc)[2][2][4][2], const Unit& u, int wr, int wc, int fr, int fq) const {
        const int row0 = u.pm * BM + wr * 64 + fr; int colt = u.pn * BM; bf16_t* base = O;
        float sc = 1.f; if (split_cols) { const int t = colt / split_cols; base += (size_t)t * split_stride; colt -= t * split_cols; if (t == 0) sc = scale0; }
        const int col0 = colt + wc * 32 + 8 * fq, bcol0 = u.pn * BM + wc * 32 + 8 * fq;
        f32x4 bv[2][2];
#pragma unroll
        for (int bj = 0; bj < 2; ++bj)
#pragma unroll
            for (int n = 0; n < 2; ++n) bv[bj][n] = bias ? *(const f32x4*)(bias + bcol0 + bj * HALF + 4 * n) : (f32x4){0.f, 0.f, 0.f, 0.f};
#pragma unroll
        for (int ai = 0; ai < 2; ++ai)
#pragma unroll
            for (int m = 0; m < 4; ++m) { bf16_t* rowp = base + (size_t)(row0 + ai * HALF + m * 16) * ldc + col0;
#pragma unroll
                for (int bj = 0; bj < 2; ++bj) { f32x4 v0 = acc[ai][bj][m][0] + bv[bj][0], v1 = acc[ai][bj][m][1] + bv[bj][1];
                    if (ACT == 1) { f32x2 a = gelu_pk((f32x2){v0[0], v0[1]}), b = gelu_pk((f32x2){v0[2], v0[3]}), c = gelu_pk((f32x2){v1[0], v1[1]}), d = gelu_pk((f32x2){v1[2], v1[3]});
                        v0 = (f32x4){a.x, a.y, b.x, b.y}; v1 = (f32x4){c.x, c.y, d.x, d.y}; }
                    v0 = v0 * sc; v1 = v1 * sc; u32x4 w; w.x = cvt_pk_bf16(v0[0], v0[1]); w.y = cvt_pk_bf16(v0[2], v0[3]); w.z = cvt_pk_bf16(v1[0], v1[1]); w.w = cvt_pk_bf16(v1[2], v1[3]);
                    *(u32x4*)(rowp + bj * HALF) = w; } }
    }
};
template <class Epi, class Sched, bool ALIGN_EPI = false, bool SP2 = false>
__device__ __forceinline__ void gemm_phase(PG8_LAS unsigned char* lds, const Gemm g, const Sched& S, const Epi& E) {
    const int tid = threadIdx.x, wid = __builtin_amdgcn_readfirstlane(tid >> 6), lane = tid & 63, wr = wid >> 2, wc = wid & 3, fr = lane & 15, fq = lane >> 4;
    const int K = g.K, nt = K / BK;
    unsigned voffA[2], voffB[2];
#pragma unroll
    for (int i = 0; i < 2; ++i) { int R, C; stage_rc(tid * 16 + i * 8192, R, C); const int Rb = Epi::PERM ? ((R & ~31) + perm32(R & 31)) : R;
        voffA[i] = (unsigned)(R * K + C) * 2u; voffB[i] = (unsigned)(Rb * K + C) * 2u; }
    const size_t kstep = (size_t)(BK * 2);
    const size_t hstep = (size_t)HALF * K * 2;
    const size_t tstep = 2 * hstep;
    const unsigned ldsw = (unsigned)wid * 1024u;
    const int aoff = lds_byte(wr * 64 + fr, fq * 8), boff = lds_byte(wc * 32 + fr, fq * 8);
#define PG8_SA(b, h) (((b) * 2 + (h)) * HTB)
#define PG8_SB(b, h) ((4 + (b) * 2 + (h)) * HTB)
#define PG8_STAGE(bufoff, gbase, voff) do { _Pragma("unroll") for (int _i = 0; _i < 2; ++_i) \
        __builtin_amdgcn_global_load_lds((const unsigned*)((const char*)(gbase) + (voff)[_i]), (PG8_LAS unsigned*)(lds + (bufoff) + ldsw + _i * 8192), 16, 0, 0); } while (0)
#define PG8_LDA(dst, b, h) do { _Pragma("unroll") for (int m = 0; m < 4; ++m) _Pragma("unroll") for (int k = 0; k < 2; ++k) dst[m][k] = *(const PG8_LAS bf16x8*)(lds + PG8_SA(b, h) + aoff + m * 2048 + k * 1024); } while (0)
#define PG8_LDB(dst, b, h) do { _Pragma("unroll") for (int n = 0; n < 2; ++n) _Pragma("unroll") for (int k = 0; k < 2; ++k) dst[n][k] = *(const PG8_LAS bf16x8*)(lds + PG8_SB(b, h) + boff + n * 2048 + k * 1024); } while (0)
#define PG8_MMA(ai, bj, At, Bt) do { __builtin_amdgcn_s_setprio(1); _Pragma("unroll") for (int m = 0; m < 4; ++m) _Pragma("unroll") for (int n = 0; n < 2; ++n) _Pragma("unroll") for (int k = 0; k < 2; ++k) \
        acc[ai][bj][m][n] = __builtin_amdgcn_mfma_f32_16x16x32_bf16(Bt[n][k], At[m][k], acc[ai][bj][m][n], 0, 0, 0); __builtin_amdgcn_s_setprio(0); } while (0)
#define PG8_WAIT_V(n) asm volatile("s_waitcnt vmcnt(" #n ")" ::: "memory")
#define PG8_WAIT_L(n) asm volatile("s_waitcnt lgkmcnt(" #n ")" ::: "memory")
#define PG8_BAR __builtin_amdgcn_s_barrier()
#define PG8_SCHED __builtin_amdgcn_sched_barrier(0)
    Unit cur, nxt; int ui = 0;
    if (!S.next(0, cur)) return;
    f32x4 acc[2][2][4][2];
#pragma unroll
    for (int a = 0; a < 2; ++a)
#pragma unroll
        for (int b = 0; b < 2; ++b)
#pragma unroll
            for (int m = 0; m < 4; ++m)
#pragma unroll
                for (int n = 0; n < 2; ++n) acc[a][b][m][n] = (f32x4){0.f, 0.f, 0.f, 0.f};
    bf16x8 At[4][2], B0[2][2], B1[2][2];
    const char* cA = (const char*)g.A + (size_t)cur.pm * tstep; const char* cB = (const char*)g.Bt + (size_t)cur.pn * tstep;
    S.a_ready(cur);
    if constexpr (SP2) {
        PG8_STAGE(PG8_SB(0, 0), cB, voffB); PG8_STAGE(PG8_SB(0, 1), cB + hstep, voffB); PG8_STAGE(PG8_SA(0, 0), cA, voffA); PG8_STAGE(PG8_SA(0, 1), cA + hstep, voffA);
        if (wr == 1) PG8_BAR;
        PG8_WAIT_V(2); PG8_BAR;
        PG8_STAGE(PG8_SB(1, 0), cB + kstep, voffB); PG8_STAGE(PG8_SA(1, 0), cA + kstep, voffA); PG8_STAGE(PG8_SB(1, 1), cB + hstep + kstep, voffB);
        PG8_WAIT_V(6); PG8_BAR;
    } else {
        PG8_STAGE(PG8_SB(0, 0), cB, voffB); PG8_STAGE(PG8_SA(0, 0), cA, voffA); PG8_STAGE(PG8_SB(0, 1), cB + hstep, voffB); PG8_STAGE(PG8_SA(0, 1), cA + hstep, voffA);
        if (wr == 1) PG8_BAR;
        PG8_WAIT_V(4); PG8_BAR;
        PG8_STAGE(PG8_SB(1, 0), cB + kstep, voffB); PG8_STAGE(PG8_SA(1, 0), cA + kstep, voffA); PG8_STAGE(PG8_SB(1, 1), cB + hstep + kstep, voffB);
        PG8_WAIT_V(6); PG8_BAR;
    }
    for (;;) {
        const bool has_next = S.next(ui + 1, nxt);
        const char* nA = has_next ? (const char*)g.A + (size_t)nxt.pm * tstep : cA; const char* nB = has_next ? (const char*)g.Bt + (size_t)nxt.pn * tstep : cB;
        for (int t = 0; t < nt; t += 2) {
            const bool last = (t == nt - 2);
            const char* a1 = cA + (size_t)(t + 1) * kstep;
            const char* a2 = last ? nA : cA + (size_t)(t + 2) * kstep; const char* b2 = last ? nB : cB + (size_t)(t + 2) * kstep;
            const char* a3 = a2 + kstep; const char* b3 = b2 + kstep;
            if (last && has_next) S.a_ready(nxt);
            if constexpr (SP2) {
            PG8_LDB(B0, 0, 0); PG8_LDB(B1, 0, 1); PG8_SCHED; PG8_LDA(At, 0, 0); PG8_STAGE(PG8_SA(1, 1), a1 + hstep, voffA);
            PG8_WAIT_V(8); PG8_WAIT_L(0); PG8_BAR; PG8_MMA(0, 0, At, B0); PG8_MMA(0, 1, At, B1); PG8_BAR; PG8_SCHED;
            PG8_LDA(At, 0, 1); PG8_STAGE(PG8_SB(0, 0), b2, voffB); PG8_STAGE(PG8_SB(0, 1), b2 + hstep, voffB); PG8_STAGE(PG8_SA(0, 0), a2, voffA);
            PG8_WAIT_V(8); PG8_WAIT_L(0); PG8_BAR; PG8_MMA(1, 0, At, B0); PG8_MMA(1, 1, At, B1); PG8_BAR; PG8_SCHED;
            PG8_LDB(B0, 1, 0); PG8_LDB(B1, 1, 1); PG8_SCHED; PG8_LDA(At, 1, 0); PG8_STAGE(PG8_SA(0, 1), a2 + hstep, voffA);
            PG8_WAIT_V(8); PG8_WAIT_L(0); PG8_BAR; PG8_MMA(0, 0, At, B0); PG8_MMA(0, 1, At, B1); PG8_BAR; PG8_SCHED;
            PG8_LDA(At, 1, 1); PG8_STAGE(PG8_SB(1, 0), b3, voffB); PG8_STAGE(PG8_SB(1, 1), b3 + hstep, voffB); PG8_STAGE(PG8_SA(1, 0), a3, voffA);
            PG8_WAIT_V(8); PG8_WAIT_L(0); PG8_BAR; PG8_MMA(1, 0, At, B0); PG8_MMA(1, 1, At, B1); PG8_BAR; PG8_SCHED;
            } else {
            PG8_LDB(B0, 0, 0); PG8_SCHED; PG8_LDA(At, 0, 0); PG8_STAGE(PG8_SA(1, 1), a1 + hstep, voffA);
            PG8_WAIT_L(8); PG8_BAR; PG8_WAIT_L(0); PG8_MMA(0, 0, At, B0); PG8_BAR; PG8_SCHED;
            PG8_LDB(B1, 0, 1); PG8_STAGE(PG8_SB(0, 0), b2, voffB);
            PG8_BAR; PG8_WAIT_L(0); PG8_MMA(0, 1, At, B1); PG8_BAR;
            PG8_LDA(At, 0, 1); PG8_STAGE(PG8_SA(0, 0), a2, voffA);
            PG8_BAR; PG8_WAIT_L(0); PG8_MMA(1, 0, At, B0); PG8_BAR; PG8_SCHED;
            PG8_STAGE(PG8_SB(0, 1), b2 + hstep, voffB);
            PG8_WAIT_V(6); PG8_BAR; PG8_MMA(1, 1, At, B1); PG8_BAR;
            PG8_LDB(B0, 1, 0); PG8_SCHED; PG8_LDA(At, 1, 0); PG8_STAGE(PG8_SA(0, 1), a2 + hstep, voffA);
            PG8_WAIT_L(8); PG8_BAR; PG8_WAIT_L(0); PG8_MMA(0, 0, At, B0); PG8_BAR; PG8_SCHED;
            PG8_LDB(B1, 1, 1); PG8_STAGE(PG8_SB(1, 0), b3, voffB);
            PG8_BAR; PG8_WAIT_L(0); PG8_MMA(0, 1, At, B1); PG8_BAR;
            PG8_LDA(At, 1, 1); PG8_STAGE(PG8_SA(1, 0), a3, voffA);
            PG8_BAR; PG8_WAIT_L(0); PG8_MMA(1, 0, At, B0); PG8_BAR; PG8_SCHED;
            PG8_STAGE(PG8_SB(1, 1), b3 + hstep, voffB);
            PG8_WAIT_V(6); PG8_BAR; PG8_MMA(1, 1, At, B1); PG8_BAR;
            }
        }
        if constexpr (ALIGN_EPI) { if (wr == 0) PG8_BAR; }
        if constexpr (!Epi::AFTER_DRAIN) { E(acc, cur, wr, wc, fr, fq); S.done(cur); }
        if (!has_next) break;
#pragma unroll
        for (int a = 0; a < 2; ++a)
#pragma unroll
            for (int b = 0; b < 2; ++b)
#pragma unroll
                for (int m = 0; m < 4; ++m)
#pragma unroll
                    for (int n = 0; n < 2; ++n) acc[a][b][m][n] = (f32x4){0.f, 0.f, 0.f, 0.f};
        cur = nxt; cA = nA; cB = nB; ++ui;
        if constexpr (ALIGN_EPI) { if (wr == 1) PG8_BAR; }
    }
    PG8_WAIT_V(0);
    if constexpr (!ALIGN_EPI) { if (wr == 0) PG8_BAR; }
    PG8_BAR;
    if constexpr (Epi::AFTER_DRAIN) { E.fused(acc, cur, wr, wc, fr, fq, lds, wid, lane); S.done(cur); }
#undef PG8_SA
#undef PG8_SB
#undef PG8_STAGE
#undef PG8_LDA
#undef PG8_LDB
#undef PG8_MMA
#undef PG8_WAIT_V
#undef PG8_WAIT_L
#undef PG8_BAR
#undef PG8_SCHED
}
}

#ifndef PG8_SP2
#define PG8_SP2 true
#endif
#ifndef PG8_ALIGN
#define PG8_ALIGN true
#endif
namespace pg8 {
constexpr float kLog2e = 1.4426950408889634f;
__device__ __forceinline__ float sigmoid_f(float x) { return __builtin_amdgcn_rcpf(1.0f + __builtin_amdgcn_exp2f(-kLog2e * x)); }
typedef unsigned u32x2 __attribute__((ext_vector_type(2)));

struct EpiIn {
    static constexpr bool PERM = true, AFTER_DRAIN = false;
    bf16_t *Q, *K, *V, *GB, *U, *VA, *GA; const float *qn, *kn; const int* pos; float qscale;
    __device__ __forceinline__ void operator()(const f32x4 (&acc)[2][2][4][2], const Unit& u, int wr, int wc, int fr, int fq) const {
        const int pn = u.pn;
        const int row0 = u.pm * BM + wr * 64 + fr;
        if (pn < 4) {
            const bool isq = pn < 2;
            const int head = (pn & 1) * 4 + wc;
            const float* gs = isq ? qn : kn; bf16_t* dst = isq ? Q : K; const float sc = isq ? qscale : 1.0f;
            f32x4 g[2][2], invf[2];
#pragma unroll
            for (int bj = 0; bj < 2; ++bj)
#pragma unroll
                for (int n = 0; n < 2; ++n) g[bj][n] = *(const f32x4*)(gs + 32 * bj + 8 * fq + 4 * n);
#pragma unroll
            for (int n = 0; n < 2; ++n)
#pragma unroll
                for (int e = 0; e < 4; ++e) invf[n][e] = __builtin_amdgcn_exp2f(-(float)(8 * fq + 4 * n + e) * 0.41524101186092f) * 0.15915494309189535f;
#pragma unroll
            for (int ai = 0; ai < 2; ++ai)
#pragma unroll
                for (int m = 0; m < 4; ++m) {
                    const int row = row0 + ai * HALF + m * 16;
                    const float p = (float)pos[row];
                    float ss = 0.f;
#pragma unroll
                    for (int bj = 0; bj < 2; ++bj)
#pragma unroll
                        for (int n = 0; n < 2; ++n) { const f32x4 v = acc[ai][bj][m][n]; ss += (v[0] * v[0] + v[1] * v[1]) + (v[2] * v[2] + v[3] * v[3]); }
                    ss += __shfl_xor(ss, 16); ss += __shfl_xor(ss, 32);
                    const float rstd = __builtin_amdgcn_rsqf(ss * (1.0f / 64.0f) + 1e-6f) * sc;
                    u32x4 w0, w1;
#pragma unroll
                    for (int n = 0; n < 2; ++n) {
                        const f32x4 y0 = acc[ai][0][m][n] * rstd * g[0][n], y1 = acc[ai][1][m][n] * rstd * g[1][n];
                        f32x4 o0, o1;
#pragma unroll
                        for (int e = 0; e < 4; ++e) {
                            float rev = p * invf[n][e]; rev = __builtin_amdgcn_fractf(rev);
                            const float c = __builtin_amdgcn_cosf(rev), s = __builtin_amdgcn_sinf(rev);
                            o0[e] = y0[e] * c - y1[e] * s; o1[e] = y1[e] * c + y0[e] * s;
                        }
                        w0[2 * n] = cvt_pk_bf16(o0[0], o0[1]); w0[2 * n + 1] = cvt_pk_bf16(o0[2], o0[3]);
                        w1[2 * n] = cvt_pk_bf16(o1[0], o1[1]); w1[2 * n + 1] = cvt_pk_bf16(o1[2], o1[3]);
                    }
                    const int b = row >> 13, s = row & 8191;
                    bf16_t* rp = dst + ((size_t)((b * 8 + head) * 8192 + s)) * 64 + 8 * fq;
                    *(u32x4*)rp = w0; *(u32x4*)(rp + 32) = w1;
                }
        } else {
            const int sec = (pn - 4) >> 1;
            const bool is_none = sec == 0, is_gelu = (sec == 2) || (sec == 3);
            const int cbase = ((pn - 4) & 1) * 256 + wc * 32 + 8 * fq;
            bf16_t* base = sec == 1 ? GB : sec == 2 ? U : sec == 3 ? VA : GA;
#pragma unroll
            for (int ai = 0; ai < 2; ++ai)
#pragma unroll
                for (int m = 0; m < 4; ++m) {
                    const int row = row0 + ai * HALF + m * 16;
#pragma unroll
                    for (int bj = 0; bj < 2; ++bj) {
                        u32x4 w;
#pragma unroll
                        for (int n = 0; n < 2; ++n) {
                            f32x4 v = acc[ai][bj][m][n];
#pragma unroll
                            for (int e = 0; e < 4; ++e) { const float x = v[e]; const float a = is_gelu ? x * (1.5957691216f + 0.0713548163f * x * x) : x; const float y = x * sigmoid_f(a); v[e] = is_none ? x : y; }
                            w[2 * n] = cvt_pk_bf16(v[0], v[1]); w[2 * n + 1] = cvt_pk_bf16(v[2], v[3]);
                        }
                        const int col = cbase + bj * HALF;
                        if (sec == 0) { const int b = row >> 13, s = row & 8191, head = col >> 6, d = col & 63; *(u32x4*)(V + ((size_t)((b * 8 + head) * 8192 + s)) * 64 + d) = w; }
                        else *(u32x4*)(base + (size_t)row * 512 + col) = w;
                    }
                }
        }
    }
};
struct EpiOut {
    static constexpr bool PERM = false, AFTER_DRAIN = false;
    const float* x; bf16_t* hb; float* ss;
    __device__ __forceinline__ void operator()(const f32x4 (&acc)[2][2][4][2], const Unit& u, int wr, int wc, int fr, int fq) const {
        const int row0 = u.pm * BM + wr * 64 + fr, col0 = u.pn * BM + wc * 32 + 4 * fq;
#pragma unroll
        for (int ai = 0; ai < 2; ++ai)
#pragma unroll
            for (int m = 0; m < 4; ++m) {
                const int row = row0 + ai * HALF + m * 16; float q = 0.f;
#pragma unroll
                for (int bj = 0; bj < 2; ++bj)
#pragma unroll
                    for (int n = 0; n < 2; ++n) {
                        const size_t off = (size_t)row * 1024 + col0 + bj * HALF + n * 16;
                        const f32x4 h = *(const f32x4*)(x + off) + acc[ai][bj][m][n];
                        q += (h[0] * h[0] + h[1] * h[1]) + (h[2] * h[2] + h[3] * h[3]);
                        u32x2 w; w.x = cvt_pk_bf16(h[0], h[1]); w.y = cvt_pk_bf16(h[2], h[3]);
                        *(u32x2*)(hb + off) = w;
                    }
                q += __shfl_xor(q, 16); q += __shfl_xor(q, 32);
                if (fq == 0) atomicAdd(ss + row, q);
            }
    }
};
struct EpiFinal {
    static constexpr bool PERM = false, AFTER_DRAIN = false;
    const bf16_t* hb; float* out; const bf16_t* proj; const float* ss; const float* bg;
    __device__ __forceinline__ void operator()(const f32x4 (&acc)[2][2][4][2], const Unit& u, int wr, int wc, int fr, int fq) const {
        const int row0 = u.pm * BM + wr * 64 + fr, col0 = u.pn * BM + wc * 32 + 4 * fq;
        f32x4 bv[2][2];
#pragma unroll
        for (int bj = 0; bj < 2; ++bj)
#pragma unroll
            for (int n = 0; n < 2; ++n) bv[bj][n] = *(const f32x4*)(bg + col0 + bj * HALF + n * 16);
#pragma unroll
        for (int ai = 0; ai < 2; ++ai)
#pragma unroll
            for (int m = 0; m < 4; ++m) {
                const int row = row0 + ai * HALF + m * 16;
                const float rstd = __builtin_amdgcn_rsqf(ss[row] * (1.0f / 1024.0f) + 1e-6f);
#pragma unroll
                for (int bj = 0; bj < 2; ++bj)
#pragma unroll
                    for (int n = 0; n < 2; ++n) {
                        const size_t off = (size_t)row * 1024 + col0 + bj * HALF + n * 16;
                        const f32x4 a = acc[ai][bj][m][n] * rstd + bv[bj][n];
                        const u32x2 hw = *(const u32x2*)(hb + off);
                        const f32x4 hv = (f32x4){__uint_as_float(hw.x << 16), __uint_as_float(hw.x & 0xffff0000u), __uint_as_float(hw.y << 16), __uint_as_float(hw.y & 0xffff0000u)};
                        const u32x2 pw = *(const u32x2*)(proj + off);
                        f32x4 o;
                        o[0] = hv[0] + sigmoid_f(a[0]) * __uint_as_float(pw.x << 16);
                        o[1] = hv[1] + sigmoid_f(a[1]) * __uint_as_float(pw.x & 0xffff0000u);
                        o[2] = hv[2] + sigmoid_f(a[2]) * __uint_as_float(pw.y << 16);
                        o[3] = hv[3] + sigmoid_f(a[3]) * __uint_as_float(pw.y & 0xffff0000u);
                        *(f32x4*)(out + off) = o;
                    }
            }
    }
};
}
#define GAS __attribute__((address_space(1)))
#define LAS __attribute__((address_space(3)))
typedef unsigned short bf16;
typedef unsigned v4u __attribute__((ext_vector_type(4)));
typedef float f32x4 __attribute__((ext_vector_type(4)));
typedef short bf16x8 __attribute__((ext_vector_type(8)));
typedef GAS unsigned gu32;
typedef GAS unsigned long long gu64;
#define RLX_AGENT __ATOMIC_RELAXED, __HIP_MEMORY_SCOPE_AGENT
#define LDS_WAIT() asm volatile("s_waitcnt lgkmcnt(0)" ::: "memory")
#define VM_WAIT() asm volatile("s_waitcnt vmcnt(0)" ::: "memory")
__device__ __forceinline__ unsigned long long rt() { return __builtin_amdgcn_s_memrealtime(); }
__device__ __forceinline__ unsigned f2bf(float f) { unsigned u = __builtin_bit_cast(unsigned, f); return (u + 0x7fffu + ((u >> 16) & 1u)) >> 16; }
__device__ __forceinline__ unsigned pk2(float lo, float hi) { return f2bf(lo) | (f2bf(hi) << 16); }

#define XB_TMO      128
#define XB_XCNT(j)  (256  + 64 * (j))
#define XB_XSUB(j)  (1280 + 64 * (j))
#define XB_XGEN(j)  (2304 + 64 * (j))
#define XB_TOP      3328
#define XB_TOPGEN   3392
#define XCD_BAR_WORDS 3456
#define XB_SPIN_CAP (1u << 18)

__device__ __forceinline__ unsigned xb_ld(unsigned* p)              { return __hip_atomic_load(p, __ATOMIC_RELAXED, __HIP_MEMORY_SCOPE_AGENT); }
__device__ __forceinline__ unsigned xb_add(unsigned* p, unsigned v) { return __hip_atomic_fetch_add(p, v, __ATOMIC_RELAXED, __HIP_MEMORY_SCOPE_AGENT); }
__device__ __forceinline__ unsigned xb_xcc_id() { return (unsigned)__builtin_amdgcn_s_getreg((3 << 11) | 20) & 0xFu; }
#define XB_SPIN(cond, bar) do { unsigned _sp = 0; while (cond) { __builtin_amdgcn_s_sleep(1); \
    if ((++_sp & 255u) == 0u) { if (xb_ld(&(bar)[XB_TMO])) break; if (_sp > XB_SPIN_CAP) { atomicAdd(&(bar)[XB_TMO], 1u); break; } } } } while (0)

struct XcdBarrier {
    unsigned* bar; unsigned x;
    volatile LAS unsigned* st;
};

__device__ __forceinline__ XcdBarrier xcd_barrier_post(unsigned* bar, volatile LAS unsigned* st) {
    XcdBarrier b; b.bar = bar; b.x = xb_xcc_id(); b.st = st;
    if (threadIdx.x == 0) (void)xb_add(&bar[XB_XCNT(b.x)], 1u);
    return b;
}
__device__ __forceinline__ void xcd_barrier_complete(unsigned* bar, unsigned x, unsigned& nloc, unsigned& nx) {
    const unsigned G = gridDim.x * gridDim.y * gridDim.z;
    unsigned sum, cnt, mine, sp = 0u;
    for (;;) {
        sum = 0u; cnt = 0u; mine = 0u;
#pragma unroll
        for (unsigned j = 0; j < 16; ++j) { const unsigned c = xb_ld(&bar[XB_XCNT(j)]); sum += c; cnt += (c > 0u) ? 1u : 0u; mine = (j == x) ? c : mine; }
        if (sum == G) break;
        __builtin_amdgcn_s_sleep(1);
        if ((++sp & 255u) == 0u) { if (xb_ld(&bar[XB_TMO])) break; if (sp > XB_SPIN_CAP) { atomicAdd(&bar[XB_TMO], 1u); break; } }
    }
    nloc = mine > 0u ? mine : 1u; nx = cnt > 0u ? cnt : 1u;
}

__device__ __forceinline__ void xcd_barrier(const XcdBarrier& b) {
    asm volatile("s_waitcnt vmcnt(0)" ::: "memory");
    __syncthreads();
    if (threadIdx.x == 0) {
        unsigned* bar = b.bar;
        __builtin_amdgcn_s_waitcnt(0);
        unsigned nloc = b.st[0], nx = b.st[1];
        if (nloc == 0u) { xcd_barrier_complete(bar, b.x, nloc, nx); b.st[0] = nloc; b.st[1] = nx; }
        const unsigned old = xb_add(&bar[XB_XSUB(b.x)], 1u);
        const unsigned gen = old / nloc;
        if (old + 1u == (gen + 1u) * nloc) {
            __builtin_amdgcn_fence(__ATOMIC_RELEASE, "agent");
            asm volatile("s_waitcnt vmcnt(0)" ::: "memory");
            const unsigned og = xb_add(&bar[XB_TOP], 1u);
            const unsigned tg = og / nx;
            if (og + 1u == (tg + 1u) * nx) xb_add(&bar[XB_TOPGEN], 1u);
            else XB_SPIN(xb_ld(&bar[XB_TOPGEN]) == tg, bar);
            __builtin_amdgcn_fence(__ATOMIC_ACQUIRE, "agent");
            xb_add(&bar[XB_XGEN(b.x)], 1u);
            asm volatile("s_waitcnt vmcnt(0)" ::: "memory");
        } else {
            XB_SPIN(xb_ld(&bar[XB_XGEN(b.x)]) == gen, bar);
            __builtin_amdgcn_fence(__ATOMIC_ACQUIRE, "agent");
            asm volatile("s_waitcnt vmcnt(0)" ::: "memory");
        }
    }
    __syncthreads();
}
constexpr int NWAVES = 8;
#ifndef MK_PLAN
#define MK_PLAN 0
#endif
constexpr int PLAN = MK_PLAN;
constexpr int NPHASE = 7;

constexpr int BATCH = 4, SEQ = 8192, DM = 1024, NH = 8, HD = 64, AW = 512, GW = 512, INC = 3584, PLE = 256;
constexpr int M = BATCH * SEQ;
constexpr float EPS = 1e-6f;

constexpr size_t MiB = 1u << 20;
constexpr size_t WS_CTL = 0, CTL_ZERO_BYTES = 1 * MiB;
constexpr size_t WS_WIN = 2 * MiB;
constexpr size_t WS_WOUT = 10 * MiB;
constexpr size_t WS_WG = 12 * MiB;
constexpr size_t WS_WP = 14 * MiB;
constexpr size_t WS_WSP = 15 * MiB;
constexpr size_t WS_SS = 512 * 1024;
constexpr size_t WS_DEN4 = 16 * MiB, WS_DEN16 = 17 * MiB;
constexpr size_t WS_PB = 18 * MiB;
constexpr size_t WS_A = 34 * MiB;
constexpr size_t WS_MIXED = WS_A;
constexpr size_t WS_Q = 98 * MiB, WS_K = 130 * MiB, WS_V = 162 * MiB;
constexpr size_t WS_HB = WS_Q;
constexpr size_t WS_GB = 194 * MiB, WS_U = 226 * MiB, WS_VA = 258 * MiB, WS_GA = 290 * MiB;
constexpr size_t WS_PROJ = WS_GB;
constexpr size_t WS_P4 = 322 * MiB, WS_P16 = 354 * MiB;
constexpr size_t WS_END = 386 * MiB;
constexpr int CW_BAR = 4096;

constexpr int RING_OFF = 0, RING_BYTES = 139264;
constexpr int LDSCTL_OFF = RING_BYTES, MISC_OFF = LDSCTL_OFF + 320;
constexpr int LDS_BYTES = 147456;
static_assert(MISC_OFF + 128 <= LDS_BYTES, "LDS map");

__device__ __forceinline__ float wave_sum(float v) {
#pragma unroll
    for (int o = 1; o < 64; o <<= 1) v += __shfl_xor(v, o);
    return v;
}
__device__ __forceinline__ float wave_max(float v) {
#pragma unroll
    for (int o = 1; o < 64; o <<= 1) v = fmaxf(v, __shfl_xor(v, o));
    return v;
}
__device__ __forceinline__ float bflo(unsigned w) { return __uint_as_float(w << 16); }
__device__ __forceinline__ float bfhi(unsigned w) { return __uint_as_float(w & 0xffff0000u); }
template <bool QKPERM> __device__ __forceinline__ void p0_transpose_item(const float* W, int K, int N, bf16* WT, const float* kscale, LAS float* scr, int item, int lane) {
    const int nblk = N / 32, kb = item / nblk, nb = item % nblk, k0 = 64 * kb, n0 = 32 * nb;
#pragma unroll 8
    for (int i = 0; i < 32; ++i) { const int kk = 2 * i + (lane >> 5); float v = W[(size_t)(k0 + kk) * N + n0 + (lane & 31)]; if (kscale) v *= kscale[k0 + kk]; scr[kk * 33 + (lane & 31)] = v; }
    LDS_WAIT(); asm volatile("" ::: "memory");
    int r0 = n0;
    if (QKPERM && n0 < 1024) { const int pn = n0 >> 8, w = n0 & 255; r0 = pn * 256 + ((w >> 5) & 1) * 128 + (w >> 6) * 32; }
    const int c = lane & 7;
#pragma unroll
    for (int j = 0; j < 4; ++j) { const int n = (lane >> 3) + 8 * j; const LAS float* s = scr + (8 * c) * 33 + n;
        v4u o; o.x = pk2(s[0 * 33], s[1 * 33]); o.y = pk2(s[2 * 33], s[3 * 33]); o.z = pk2(s[4 * 33], s[5 * 33]); o.w = pk2(s[6 * 33], s[7 * 33]);
        *(GAS v4u*)(WT + (size_t)(r0 + n) * K + k0 + 8 * c) = o; }
    LDS_WAIT(); asm volatile("" ::: "memory");
}

namespace att {
typedef short bf16x8 __attribute__((ext_vector_type(8)));
typedef short v4i16 __attribute__((ext_vector_type(4)));
typedef float f32x16 __attribute__((ext_vector_type(16)));
typedef unsigned u32x4 __attribute__((ext_vector_type(4)));
typedef unsigned u32x2 __attribute__((ext_vector_type(2)));
constexpr int KOFF = 0, VOFF = 384 * 128, STG = 2 * 384 * 128, STG_ROW = 144, STG_W = 32 * STG_ROW, DSC = STG + 8 * STG_W, ATT_LDS = DSC + 8 * 32 * 4;
static_assert(ATT_LDS <= RING_BYTES, "attention LDS");
__device__ __forceinline__ int crow(int r, int hi) { return (r & 3) + 8 * (r >> 2) + 4 * hi; }
typedef float f32x2_t __attribute__((ext_vector_type(2))); typedef __bf16 bf16x2_t __attribute__((ext_vector_type(2)));
__device__ __forceinline__ unsigned cvtpk(float lo, float hi) { f32x2_t v = {lo, hi}; bf16x2_t b = __builtin_convertvector(v, bf16x2_t); return __builtin_bit_cast(unsigned, b); }
struct Tens { const bf16 *Q, *K, *V; bf16 *P4, *P16; float *D4, *D16; const bf16* GB; bf16* MIXED; };
struct Unit { int R, b, h, res, blk; };
struct Pre { u32x4 kv[6], vv[6]; bf16x8 qf[4]; };

__device__ __forceinline__ void unit_load(Pre& P, const Tens& T, const Unit& u, int tid, int wid, int r32, int hi) {
    const size_t hb = (size_t)(u.b * NH + u.h) * SEQ * HD;
    const int l0 = u.blk * 256, ch = tid & 7;
#pragma unroll
    for (int i = 0; i < 6; ++i) {
        const int row = (tid >> 3) + 64 * i, l = l0 - 128 + row;
        if (l >= 0) { const size_t off = hb + (size_t)(l * u.R + u.res) * HD + ch * 8; P.kv[i] = *(const GAS u32x4*)(T.K + off); P.vv[i] = *(const GAS u32x4*)(T.V + off); }
        else { P.kv[i] = (u32x4){0u, 0u, 0u, 0u}; P.vv[i] = (u32x4){0u, 0u, 0u, 0u}; }
    }
    const size_t qoff = hb + (size_t)((l0 + 32 * wid + r32) * u.R + u.res) * HD + 8 * hi;
#pragma unroll
    for (int ks = 0; ks < 4; ++ks) P.qf[ks] = *(const GAS bf16x8*)(T.Q + qoff + 16 * ks);
}
__device__ __forceinline__ void unit_stage(const Pre& P, LAS unsigned char* lds, int tid) {
    const int ch = tid & 7;
#pragma unroll
    for (int i = 0; i < 6; ++i) {
        const int row = (tid >> 3) + 64 * i;
        *(LAS u32x4*)(lds + KOFF + row * 128 + ((ch ^ ((row >> 1) & 7)) << 4)) = P.kv[i];
        *(LAS u32x4*)(lds + VOFF + row * 128 + ((ch ^ (((row >> 1) & 1) << 2)) << 4)) = P.vv[i];
    }
}
template <bool MERGE> __device__ __forceinline__ void unit_compute(const bf16x8 (&qf)[4], LAS unsigned char* lds, const Tens& T, const Unit& u, float negM, int lane, int wid, int r32, int hi) {
    f32x16 oT[2]; float dsum = 0.f;
#pragma unroll
    for (int r = 0; r < 16; ++r) { oT[0][r] = 0.f; oT[1][r] = 0.f; }
    const int q4 = (lane & 15) >> 2, p4 = lane & 3, g1 = (lane >> 4) & 1;
#pragma unroll
    for (int j = 0; j < 5; ++j) {
        if (u.blk == 0 && wid + j < 4) continue;
        const int rb = 32 * (wid + j), krow = rb + r32, ksw = (krow >> 1) & 7;
        const LAS unsigned char* kp = lds + KOFF + krow * 128;
        f32x16 p;
#pragma unroll
        for (int r = 0; r < 16; ++r) p[r] = negM;
#pragma unroll
        for (int ks = 0; ks < 4; ++ks) { const bf16x8 kf = *(const LAS bf16x8*)(kp + (((2 * ks + hi) ^ ksw) << 4)); p = __builtin_amdgcn_mfma_f32_32x32x16_bf16(kf, qf[ks], p, 0, 0, 0); }
        if (j == 0) {
#pragma unroll
            for (int r = 0; r < 16; ++r) if (crow(r, hi) < r32) p[r] = -INFINITY;
        }
        if (j == 4) {
#pragma unroll
            for (int r = 0; r < 16; ++r) if (crow(r, hi) > r32) p[r] = -INFINITY;
        }
#pragma unroll
        for (int r = 0; r < 16; ++r) { p[r] = __builtin_amdgcn_exp2f(p[r]); dsum += p[r]; }
        bf16x8 pa[2];
#pragma unroll
        for (int s = 0; s < 2; ++s) { u32x4 w; w.x = cvtpk(p[8 * s + 0], p[8 * s + 1]); w.y = cvtpk(p[8 * s + 2], p[8 * s + 3]); w.z = cvtpk(p[8 * s + 4], p[8 * s + 5]); w.w = cvtpk(p[8 * s + 6], p[8 * s + 7]); pa[s] = __builtin_bit_cast(bf16x8, w); }
#pragma unroll
        for (int s = 0; s < 2; ++s)
#pragma unroll
            for (int db = 0; db < 2; ++db) {
                const int vrow = rb + 16 * s + 4 * hi + q4, chn = 4 * db + 2 * g1 + (p4 >> 1);
                const LAS unsigned char* vp = lds + VOFF + vrow * 128 + ((chn ^ (((vrow >> 1) & 1) << 2)) << 4) + 8 * (p4 & 1);
                const v4i16 lo = __builtin_amdgcn_ds_read_tr16_b64_v4i16((LAS v4i16*)vp);
                const v4i16 hh = __builtin_amdgcn_ds_read_tr16_b64_v4i16((LAS v4i16*)(vp + 1024));
                const bf16x8 vf = (bf16x8){lo[0], lo[1], lo[2], lo[3], hh[0], hh[1], hh[2], hh[3]};
                oT[db] = __builtin_amdgcn_mfma_f32_32x32x16_bf16(vf, pa[s], oT[db], 0, 0, 0);
            }
    }
    const float dtot = dsum + __shfl_xor(dsum, 32);
    LAS unsigned char* stg = lds + STG + wid * STG_W;
    LAS float* dsc = (LAS float*)(lds + DSC) + wid * 32;
#pragma unroll
    for (int db = 0; db < 2; ++db)
#pragma unroll
        for (int r4 = 0; r4 < 4; ++r4) { u32x2 w; w.x = cvtpk(oT[db][4 * r4 + 0], oT[db][4 * r4 + 1]); w.y = cvtpk(oT[db][4 * r4 + 2], oT[db][4 * r4 + 3]);
            *(LAS u32x2*)(stg + r32 * STG_ROW + (32 * db + 8 * r4 + 4 * hi) * 2) = w; }
    const int l0 = u.blk * 256;
    const size_t growq = (size_t)u.b * SEQ + (size_t)((l0 + 32 * wid + r32) * u.R + u.res);
    if (MERGE) { if (hi == 0) dsc[r32] = dtot; }
    else { if (hi == 0) { float* D = (u.R == 4) ? T.D4 : T.D16; D[growq * NH + u.h] = dtot; } }
    asm volatile("s_waitcnt lgkmcnt(0)" ::: "memory");
#pragma unroll
    for (int i = 0; i < 4; ++i) {
        const int row = (lane >> 3) + 8 * i, ch = lane & 7;
        const u32x4 v = *(const LAS u32x4*)(stg + row * STG_ROW + ch * 16);
        const size_t grow = (size_t)u.b * SEQ + (size_t)((l0 + 32 * wid + row) * u.R + u.res);
        const size_t poff = grow * AW + u.h * HD + ch * 8;
        if (!MERGE) { bf16* Pd = (u.R == 4) ? T.P4 : T.P16; *(GAS u32x4*)(Pd + poff) = v; }
        else {
            const u32x4 a = *(const GAS u32x4*)(T.P4 + poff), c = *(const GAS u32x4*)(T.P16 + poff), g = *(const GAS u32x4*)(T.GB + poff);
            const float d = dsc[row] + T.D4[grow * NH + u.h] + T.D16[grow * NH + u.h];
            const float inv = 1.0f / d;
            u32x4 o;
#pragma unroll
            for (int e = 0; e < 4; ++e) {
                const float x0 = (bflo(v[e]) + bflo(a[e]) + bflo(c[e])) * inv * bflo(g[e]);
                const float x1 = (bfhi(v[e]) + bfhi(a[e]) + bfhi(c[e])) * inv * bfhi(g[e]);
                o[e] = cvtpk(x0, x1);
            }
            *(GAS u32x4*)(T.MIXED + grow * DM + u.h * HD + ch * 8) = o;
        }
    }
}
__device__ __forceinline__ Unit unit_of(int idx, bool merge) {
    Unit u;
    if (merge) { u.R = 1; const int bh = idx >> 5; u.b = bh >> 3; u.h = bh & 7; u.res = 0; u.blk = idx & 31; }
    else { const int br = idx >> 10, w = idx & 1023, bh = w >> 5, rb = w & 31; u.b = bh >> 3; u.h = bh & 7;
        if (br == 0) { u.R = 16; u.res = rb >> 1; u.blk = rb & 1; } else { u.R = 4; u.res = rb >> 3; u.blk = rb & 7; } }
    return u;
}
template <bool MERGE> __device__ __forceinline__ void attn_phase(LAS unsigned char* lds, const Tens& T, int vcu, int G, const float* qn, const float* kn) {
    const int tid = threadIdx.x, lane = tid & 63, r32 = lane & 31, hi = lane >> 5, wid = __builtin_amdgcn_readfirstlane(tid >> 6);
    const int total = MERGE ? 1024 : 2048;
    const float mq = wave_max(fabsf(qn[lane])), mk = wave_max(fabsf(kn[lane]));
    const float negM = -8.0f * mq * mk * 1.4426950408889634f;
    Pre P;
    int idx = vcu;
    if (idx < total) { const Unit u = unit_of(idx, MERGE); unit_load(P, T, u, tid, wid, r32, hi); }
    for (; idx < total; idx += G) {
        const Unit u = unit_of(idx, MERGE);
        unit_stage(P, lds, tid);
        bf16x8 qf[4];
#pragma unroll
        for (int ks = 0; ks < 4; ++ks) qf[ks] = P.qf[ks];
        __syncthreads();
        if (idx + G < total) { const Unit un = unit_of(idx + G, MERGE); unit_load(P, T, un, tid, wid, r32, hi); }
        unit_compute<MERGE>(qf, lds, T, u, negM, lane, wid, r32, hi);
        __syncthreads();
    }
}
}

namespace gm {
typedef short bf16x8 __attribute__((ext_vector_type(8)));
typedef short v4i16 __attribute__((ext_vector_type(4)));
typedef float f32x16 __attribute__((ext_vector_type(16)));
typedef unsigned u32x4 __attribute__((ext_vector_type(4)));
__device__ __forceinline__ int crow(int r, int hi) { return (r & 3) + 8 * (r >> 2) + 4 * hi; }
__device__ __forceinline__ void gmlp_unit(LAS unsigned char* lds, int uc, const bf16* VA, const bf16* U, const bf16* GA, const bf16* WSb, const float* bs, const float* lng, const float* lnb, bf16* MIXED) {
    const int tid = threadIdx.x, lane = tid & 63, r32 = lane & 31, hi = lane >> 5, wid = __builtin_amdgcn_readfirstlane(tid >> 6);
    const size_t T0 = (size_t)uc * 128;
    float lg[8], lb[8];
#pragma unroll
    for (int e = 0; e < 8; ++e) { lg[e] = lng[lane * 8 + e]; lb[e] = lnb[lane * 8 + e]; }
#pragma unroll 4
    for (int rr = 0; rr < 16; ++rr) {
        const int row = 16 * wid + rr;
        const u32x4 w = *(const GAS u32x4*)(VA + (T0 + row) * GW + lane * 8);
        float v[8];
#pragma unroll
        for (int e = 0; e < 4; ++e) { v[2 * e] = bflo(w[e]); v[2 * e + 1] = bfhi(w[e]); }
        float s = 0.f;
#pragma unroll
        for (int e = 0; e < 8; ++e) s += v[e];
        const float mean = wave_sum(s) * (1.0f / 512.0f);
        float q = 0.f;
#pragma unroll
        for (int e = 0; e < 8; ++e) { v[e] -= mean; q += v[e] * v[e]; }
        const float rstd = 1.0f / sqrtf(wave_sum(q) * (1.0f / 512.0f) + EPS);
        u32x4 o;
#pragma unroll
        for (int e = 0; e < 4; ++e) o[e] = pk2(v[2 * e] * rstd * lg[2 * e] + lb[2 * e], v[2 * e + 1] * rstd * lg[2 * e + 1] + lb[2 * e + 1]);
        *(LAS u32x4*)(lds + (lane >> 3) * 16384 + row * 128 + (((lane & 7) ^ (((row >> 1) & 1) << 2)) << 4)) = o;
    }
    __syncthreads();
    const int g = wid >> 1;
    const bf16* Wg = WSb + (size_t)g * 128 * 128;
    const LAS unsigned char* img = lds + wid * 16384;
    const int q4 = (lane & 15) >> 2, p4 = lane & 3, g1 = (lane >> 4) & 1;
#pragma unroll 1
    for (int tt = 0; tt < 4; ++tt) {
        f32x16 acc[2];
#pragma unroll
        for (int r = 0; r < 16; ++r) { acc[0][r] = 0.f; acc[1][r] = 0.f; }
        const int nks = 2 * tt + 2;
        for (int ks = 0; ks < nks; ++ks) {
            const bf16x8 a = *(const GAS bf16x8*)(Wg + (size_t)(32 * tt + r32) * 128 + 16 * ks + 8 * hi);
#pragma unroll
            for (int dt = 0; dt < 2; ++dt) {
                const int vrow = 16 * ks + 8 * hi + q4, chn = 4 * dt + 2 * g1 + (p4 >> 1);
                const LAS unsigned char* vp = img + vrow * 128 + ((chn ^ (((vrow >> 1) & 1) << 2)) << 4) + 8 * (p4 & 1);
                const v4i16 lo = __builtin_amdgcn_ds_read_tr16_b64_v4i16((LAS v4i16*)vp);
                const v4i16 hh = __builtin_amdgcn_ds_read_tr16_b64_v4i16((LAS v4i16*)(vp + 512));
                const bf16x8 vf = (bf16x8){lo[0], lo[1], lo[2], lo[3], hh[0], hh[1], hh[2], hh[3]};
                acc[dt] = __builtin_amdgcn_mfma_f32_32x32x16_bf16(a, vf, acc[dt], 0, 0, 0);
            }
        }
#pragma unroll
        for (int r = 0; r < 16; ++r) {
            const int t = 32 * tt + crow(r, hi);
            const float bias = bs[g * 128 + t];
#pragma unroll
            for (int dt = 0; dt < 2; ++dt) {
                const int col = 64 * wid + 32 * dt + r32;
                const size_t off = (T0 + t) * GW + col;
                const float uu = __uint_as_float((unsigned)U[off] << 16), ga = __uint_as_float((unsigned)GA[off] << 16);
                MIXED[(T0 + t) * DM + AW + col] = (bf16)f2bf(uu * (acc[dt][r] + bias) * ga);
            }
        }
    }
    __syncthreads();
}
}

struct Args { const void* in[16]; float* out; unsigned char* ws; int ph_lo, ph_hi, li, pad; };
__global__ void __launch_bounds__(NWAVES * 64, 2) mk_fwd(Args args) {
    extern __shared__ __attribute__((aligned(16))) unsigned char lds_raw[];
    LAS unsigned char* lds = (LAS unsigned char*)lds_raw;
    volatile LAS unsigned* MISC = (volatile LAS unsigned*)(lds + MISC_OFF);
    const int tid = threadIdx.x, lane = tid & 63, wave = __builtin_amdgcn_readfirstlane(tid >> 6);
    const int G = gridDim.x, bx = blockIdx.x, vcu = (G % 8 == 0) ? (bx % 8) * (G / 8) + bx / 8 : bx;
    unsigned char* ws = args.ws;
    gu32* ctl = (gu32*)(ws + WS_CTL);
    const float* x = (const float*)args.in[0]; const float* pin = (const float*)args.in[1]; const int* pos = (const int*)args.in[2];
    const float* g_in = (const float*)args.in[3]; const float* w_in = (const float*)args.in[4]; const float* qn = (const float*)args.in[5]; const float* kn = (const float*)args.in[6];
    const float* w_sp = (const float*)args.in[7]; const float* b_sp = (const float*)args.in[8]; const float* lng = (const float*)args.in[9]; const float* lnb = (const float*)args.in[10];
    const float* w_out = (const float*)args.in[11]; const float* g_ple = (const float*)args.in[12]; const float* w_g = (const float*)args.in[13]; const float* b_g = (const float*)args.in[14]; const float* w_p = (const float*)args.in[15];
    float* out = args.out;
    bf16 *Win_t = (bf16*)(ws + WS_WIN), *Wout_t = (bf16*)(ws + WS_WOUT), *Wg_t = (bf16*)(ws + WS_WG), *Wp_t = (bf16*)(ws + WS_WP), *WSb = (bf16*)(ws + WS_WSP);
    float* SS = (float*)(ws + WS_SS); float* DEN4 = (float*)(ws + WS_DEN4); float* DEN16 = (float*)(ws + WS_DEN16);
    bf16 *PB = (bf16*)(ws + WS_PB), *A = (bf16*)(ws + WS_A), *MIXED = (bf16*)(ws + WS_MIXED), *QB = (bf16*)(ws + WS_Q), *KB = (bf16*)(ws + WS_K), *VB = (bf16*)(ws + WS_V), *HB = (bf16*)(ws + WS_HB);
    bf16 *GB = (bf16*)(ws + WS_GB), *UB = (bf16*)(ws + WS_U), *VA = (bf16*)(ws + WS_VA), *GA = (bf16*)(ws + WS_GA), *PROJ = (bf16*)(ws + WS_PROJ), *P4 = (bf16*)(ws + WS_P4), *P16 = (bf16*)(ws + WS_P16);

    for (int u = tid; u < (LDS_BYTES - LDSCTL_OFF) / 4; u += NWAVES * 64) ((LAS unsigned*)(lds + LDSCTL_OFF))[u] = 0u;
    __syncthreads();
    XcdBarrier bar; bar.bar = (unsigned*)(ctl + CW_BAR); bar.x = 0; bar.st = nullptr;
    const bool multi = (args.ph_hi - args.ph_lo) > 1;
    if (multi) bar = xcd_barrier_post((unsigned*)(ctl + CW_BAR) + args.li * XCD_BAR_WORDS, MISC + 8);
#define GRID_BAR() xcd_barrier(bar)
    const int lo = args.ph_lo, hi_ph = args.ph_hi;
#define IN(k) (lo <= (k) && (k) < hi_ph)

    if (IN(0)) { {
        LAS float* scr = (LAS float*)(lds + RING_OFF + wave * 16384);
        const int gw = vcu * NWAVES + wave, NGW = G * NWAVES;
        constexpr int I_IN = (DM / 64) * (INC / 32), I_OUT = (DM / 64) * (DM / 32), I_G = I_OUT, I_P = (PLE / 64) * (DM / 32);
        constexpr int NITEMS = I_IN + I_OUT + I_G + I_P;
        for (int it = gw; it < NITEMS; it += NGW) {
            int r = it;
            if (r < I_IN) { p0_transpose_item<true>(w_in, DM, INC, Win_t, nullptr, scr, r, lane); continue; } r -= I_IN;
            if (r < I_OUT) { p0_transpose_item<false>(w_out, DM, DM, Wout_t, nullptr, scr, r, lane); continue; } r -= I_OUT;
            if (r < I_G) { p0_transpose_item<false>(w_g, DM, DM, Wg_t, g_ple, scr, r, lane); continue; } r -= I_G;
            p0_transpose_item<false>(w_p, PLE, DM, Wp_t, nullptr, scr, r, lane);
        }
        const int gt = vcu * NWAVES * 64 + tid, NGT = G * NWAVES * 64;
        for (int i = gt; i < 4 * 128 * 128; i += NGT) { const int s = i & 127, t = (i >> 7) & 127; WSb[i] = (bf16)f2bf(s <= t ? w_sp[i] : 0.0f); }
        f32x4 gv[4];
#pragma unroll
        for (int j = 0; j < 4; ++j) gv[j] = *((const GAS f32x4*)g_in + lane + 64 * j);
        for (int m = gw; m < M; m += NGW) {
            const GAS f32x4* xr = (const GAS f32x4*)(x + (size_t)m * DM) + lane;
            f32x4 v[4]; float s2 = 0.f;
#pragma unroll
            for (int j = 0; j < 4; ++j) { v[j] = xr[64 * j]; s2 += (v[j].x * v[j].x + v[j].y * v[j].y) + (v[j].z * v[j].z + v[j].w * v[j].w); }
            const float rstd = 1.0f / sqrtf(wave_sum(s2) * (1.0f / DM) + EPS);
            GAS unsigned long long* o8 = (GAS unsigned long long*)(A + (size_t)m * DM) + lane;
#pragma unroll
            for (int j = 0; j < 4; ++j) o8[64 * j] = (unsigned long long)pk2(v[j].x * rstd * gv[j].x, v[j].y * rstd * gv[j].y) | ((unsigned long long)pk2(v[j].z * rstd * gv[j].z, v[j].w * rstd * gv[j].w) << 32);
            const f32x4 pv = *((const GAS f32x4*)(pin + (size_t)m * PLE) + lane);
            *((GAS unsigned long long*)(PB + (size_t)m * PLE) + lane) = (unsigned long long)pk2(pv.x, pv.y) | ((unsigned long long)pk2(pv.z, pv.w) << 32);
        } }
        if (IN(1)) GRID_BAR();
    }
    if (IN(1)) {
        pg8::Gemm g{A, Win_t, M, INC, DM}; pg8::StaticOrder S; S.init(M, INC, G, bx);
        pg8::EpiIn E{QB, KB, VB, GB, UB, VA, GA, qn, kn, pos, 0.125f * 1.4426950408889634f};
        pg8::gemm_phase<pg8::EpiIn, pg8::StaticOrder, PG8_ALIGN, PG8_SP2>(lds + RING_OFF, g, S, E);
        if (IN(2)) GRID_BAR();
    }
    att::Tens AT{QB, KB, VB, P4, P16, DEN4, DEN16, GB, MIXED};
    if (IN(2)) att::attn_phase<false>(lds + RING_OFF, AT, vcu, G, qn, kn);
    if (IN(3)) {
        for (int uc = vcu; uc < M / 128; uc += G) gm::gmlp_unit(lds + RING_OFF, uc, VA, UB, GA, WSb, b_sp, lng, lnb, MIXED);
        if (IN(4)) GRID_BAR();
    }
    if (IN(4)) {
        att::attn_phase<true>(lds + RING_OFF, AT, vcu, G, qn, kn);
        if (IN(5)) GRID_BAR();
    }
    if (IN(5)) {
        { pg8::Gemm g{MIXED, Wout_t, M, DM, DM}; pg8::StaticOrder S; S.init(M, DM, G, bx);
          pg8::EpiOut E{x, HB, SS};
          pg8::gemm_phase<pg8::EpiOut, pg8::StaticOrder, PG8_ALIGN, PG8_SP2>(lds + RING_OFF, g, S, E); }
        { pg8::Gemm g{PB, Wp_t, M, DM, PLE}; pg8::StaticOrder S; S.init(M, DM, G, bx);
          pg8::EpiBf16<0> E{PROJ, DM, nullptr, 0, 0, 1.f};
          pg8::gemm_phase<pg8::EpiBf16<0>, pg8::StaticOrder, PG8_ALIGN, PG8_SP2>(lds + RING_OFF, g, S, E); }
        if (IN(6)) GRID_BAR();
    }
    if (IN(6)) {
        pg8::Gemm g{HB, Wg_t, M, DM, DM}; pg8::StaticOrder S; S.init(M, DM, G, bx);
        pg8::EpiFinal E{HB, out, PROJ, SS, b_g};
        pg8::gemm_phase<pg8::EpiFinal, pg8::StaticOrder, PG8_ALIGN, PG8_SP2>(lds + RING_OFF, g, S, E);
    }
#undef IN
#undef GRID_BAR
}

extern "C" void kernel_launch(void* const* d_in, const int* in_sizes, int n_in, void* d_out, int out_size, void* d_ws, size_t ws_size, hipStream_t stream) {
    static int grid = 0;
    if (grid == 0) {
        if (n_in != 16 || in_sizes[0] != M * DM || out_size != M * DM || ws_size < WS_END) { fprintf(stderr, "kernel_launch: unexpected shapes (n_in %d, in0 %d, out %d, ws %zu); nothing launched\n", n_in, n_in > 0 ? in_sizes[0] : -1, out_size, ws_size); grid = -1; return; }
        int dev = 0, cus = 0, per_cu = 0;
        if (hipGetDevice(&dev) != hipSuccess || hipDeviceGetAttribute(&cus, hipDeviceAttributeMultiprocessorCount, dev) != hipSuccess) { grid = -1; return; }
        if (hipFuncSetAttribute((const void*)mk_fwd, hipFuncAttributeMaxDynamicSharedMemorySize, LDS_BYTES) != hipSuccess) { fprintf(stderr, "kernel_launch: hipFuncSetAttribute failed\n"); grid = -1; return; }
        if (hipOccupancyMaxActiveBlocksPerMultiprocessor(&per_cu, (const void*)mk_fwd, NWAVES * 64, LDS_BYTES) != hipSuccess || per_cu < 1) fprintf(stderr, "kernel_launch: occupancy query reports %d per CU\n", per_cu);
        (void)hipGetLastError();
        grid = cus;
    }
    if (grid < 0) return;
    if (hipMemsetAsync((char*)d_ws + WS_CTL, 0, CTL_ZERO_BYTES, stream) != hipSuccess) return;
    Args a{};
    for (int i = 0; i < 16; ++i) a.in[i] = d_in[i];
    a.out = (float*)d_out; a.ws = (unsigned char*)d_ws;
    int los[8], his[8], nl = 0;
    if (PLAN == 0) { los[0] = 0; his[0] = NPHASE; nl = 1; }
    else if (PLAN == 1) { for (int k = 0; k < NPHASE; ++k) { los[k] = k; his[k] = k + 1; } nl = NPHASE; }
    else { const int k = PLAN - 10; los[0] = 0; his[0] = k + 1; los[1] = k; his[1] = k + 1; nl = 2; if (k + 1 < NPHASE) { los[2] = k + 1; his[2] = NPHASE; nl = 3; } }
    for (int li = 0; li < nl; ++li) {
        a.ph_lo = los[li]; a.ph_hi = his[li]; a.li = li;
        hipLaunchKernelGGL(mk_fwd, dim3(grid), dim3(NWAVES * 64), LDS_BYTES, stream, a);
        const hipError_t le = hipPeekAtLastError();
        if (le != hipSuccess) { fprintf(stderr, "kernel_launch: launch %d failed: %s\n", li, hipGetErrorName(le)); break; }
    }
}
```

```cpp
#define MK_PLAN 0
#include <hip/hip_runtime.h>
#include <cstdio>
#include <cstdint>
namespace pg8 {
#define PG8_LAS __attribute__((address_space(3)))
typedef unsigned short bf16_t;
typedef short bf16x8 __attribute__((ext_vector_type(8)));
typedef float f32x4 __attribute__((ext_vector_type(4)));
typedef unsigned u32x4 __attribute__((ext_vector_type(4)));
constexpr int BM = 256, BK = 64, HALF = 128, HTB = HALF * BK * 2  , STAGE_BYTES = 8 * HTB, NXCD = 8, WGM = 8;

__host__ __device__ __forceinline__ int lds_byte(int r, int c) { const int st = (r >> 4) * 2 + (c >> 5), rr = r & 15, cc = c & 31, ob = rr * 64 + cc * 2; return st * 1024 + (ob ^ (((ob >> 9) & 1) << 5)); }
__host__ __device__ __forceinline__ void stage_rc(int b, int& R, int& C) { const int st = b / 1024, sb = b % 1024, swz = sb ^ (((sb >> 9) & 1) << 5); R = (st >> 1) * 16 + swz / 64; C = (st & 1) * 32 + (swz % 64) / 2; }
__host__ __device__ __forceinline__ int perm32(int rho) { const int n = rho >> 4, i = rho & 15; return 8 * (i >> 2) + 4 * n + (i & 3); }

struct Unit { int pm, pn; };
struct Gemm { const bf16_t* A; const bf16_t* Bt; int M, N, K; };

struct StaticOrder {
    int nM, nN, nwg, G, c;
    __host__ __device__ void init(int M, int N, int G_, int c_) { nM = M / BM; nN = N / BM; nwg = nM * nN; G = G_; c = c_; }
    __host__ __device__ bool next(int i, Unit& u) const {
        const long L = (long)i * G + c; if (L >= nwg) return false;
        int wgid = (int)L; { const int q = nwg / NXCD, r = nwg % NXCD, xcd = wgid % NXCD, off = wgid / NXCD; wgid = (xcd < r ? xcd * (q + 1) : r * (q + 1) + (xcd - r) * q) + off; }
        const int nig = WGM * nN, gid = wgid / nig, fm = gid * WGM, gsz = (nM - fm) < WGM ? (nM - fm) : WGM;
        u.pm = fm + ((wgid % nig) % gsz); u.pn = (wgid % nig) / gsz; return true;
    }
    __device__ __forceinline__ void a_ready(const Unit&) const {}
    __device__ __forceinline__ void done(const Unit&) const {}
};

typedef float f32x2c_t __attribute__((ext_vector_type(2))); typedef __bf16 bf16x2c_t __attribute__((ext_vector_type(2)));
__device__ __forceinline__ unsigned cvt_pk_bf16(float lo, float hi) { f32x2c_t v = {lo, hi}; bf16x2c_t b = __builtin_convertvector(v, bf16x2c_t); return __builtin_bit_cast(unsigned, b); }
typedef float f32x2 __attribute__((ext_vector_type(2)));
__device__ __forceinline__ f32x2 gelu_pk(f32x2 v) {
    const f32x2 av = __builtin_elementwise_abs(v), d = av * 0.2316418882f + 1.0f;
    f32x2 t; t.x = __builtin_amdgcn_rcpf(d.x); t.y = __builtin_amdgcn_rcpf(d.y);
    f32x2 q = t * 0.5307027145f + (-0.7265760135f); q = q * t + 0.7107068705f; q = q * t + (-0.142248368f); q = q * t + 0.127414796f; q = q * t;
    const f32x2 s = (v * v) * (-0.72134752044f);
    f32x2 e; e.x = __builtin_amdgcn_exp2f(s.x); e.y = __builtin_amdgcn_exp2f(s.y);
    const f32x2 m = v * (q * e), r = v - m;
    f32x2 o; o.x = v.x < 0.f ? m.x : r.x; o.y = v.y < 0.f ? m.y : r.y; return o;
}

template <int ACT  > struct EpiBf16 {
    static constexpr bool PERM = true, AFTER_DRAIN = false; static_assert(ACT == 0 || ACT == 1, "EpiBf16: ACT is 0 (none) or 1 (gelu_pk)");
    bf16_t* O; int ldc; const float* bias; int split_cols; size_t split_stride; float scale0;
    __device__ __forceinline__ void operator()(const f32x4 (&acc)[2][2][4][2], const Unit& u, int wr, int wc, int fr, int fq) const {
        const int row0 = u.pm * BM + wr * 64 + fr; int colt = u.pn * BM; bf16_t* base = O;
        float sc = 1.f; if (split_cols) { const int t = colt / split_cols; base += (size_t)t * split_stride; colt -= t * split_cols; if (t == 0) sc = scale0; }
        const int col0 = colt + wc * 32 + 8 * fq, bcol0 = u.pn * BM + wc * 32 + 8 * fq;
        f32x4 bv[2][2];
#pragma unroll
        for (int bj = 0; bj < 2; ++bj)
#pragma unroll
            for (int n = 0; n < 2; ++n) bv[bj][n] = bias ? *(const f32x4*)(bias + bcol0 + bj * HALF + 4 * n) : (f32x4){0.f, 0.f, 0.f, 0.f};
#pragma unroll
        for (int ai = 0; ai < 2; ++ai)
#pragma unroll
            for (int m = 0; m < 4; ++m) { bf16_t* rowp = base + (size_t)(row0 + ai * HALF + m * 16) * ldc + col0;
#pragma unroll
                for (int bj = 0; bj < 2; ++bj) { f32x4 v0 = acc[ai][bj][m][0] + bv[bj][0], v1 = acc[ai][bj][m][1] + bv[bj][1];
                    if (ACT == 1) { f32x2 a = gelu_pk((f32x2){v0[0], v0[1]}), b = gelu_pk((f32x2){v0[2], v0[3]}), c = gelu_pk((f32x2){v1[0], v1[1]}), d = gelu_pk((f32x2){v1[2], v1[3]});
                        v0 = (f32x4){a.x, a.y, b.x, b.y}; v1 = (f32x4){c.x, c.y, d.x, d.y}; }
                    v0 = v0 * sc; v1 = v1 * sc; u32x4 w; w.x = cvt_pk_bf16(v0[0], v0[1]); w.y = cvt_pk_bf16(v0[2], v0[3]); w.z = cvt_pk_bf16(v1[0], v1[1]); w.w = cvt_pk_bf16(v1[2], v1[3]);
                    *(u32x4*)(rowp + bj * HALF) = w; } }
    }
};
template <class Epi, class Sched, bool ALIGN_EPI = false, bool SP2 = false>
__device__ __forceinline__ void gemm_phase(PG8_LAS unsigned char* lds, const Gemm g, const Sched& S, const Epi& E) {
    const int tid = threadIdx.x, wid = __builtin_amdgcn_readfirstlane(tid >> 6), lane = tid & 63, wr = wid >> 2, wc = wid & 3, fr = lane & 15, fq = lane >> 4;
    const int K = g.K, nt = K / BK;
    unsigned voffA[2], voffB[2];
#pragma unroll
    for (int i = 0; i < 2; ++i) { int R, C; stage_rc(tid * 16 + i * 8192, R, C); const int Rb = Epi::PERM ? ((R & ~31) + perm32(R & 31)) : R;
        voffA[i] = (unsigned)(R * K + C) * 2u; voffB[i] = (unsigned)(Rb * K + C) * 2u; }
    const size_t kstep = (size_t)(BK * 2);
    const size_t hstep = (size_t)HALF * K * 2;
    const size_t tstep = 2 * hstep;
    const unsigned ldsw = (unsigned)wid * 1024u;
    const int aoff = lds_byte(wr * 64 + fr, fq * 8), boff = lds_byte(wc * 32 + fr, fq * 8);
#define PG8_SA(b, h) (((b) * 2 + (h)) * HTB)
#define PG8_SB(b, h) ((4 + (b) * 2 + (h)) * HTB)
#define PG8_STAGE(bufoff, gbase, voff) do { _Pragma("unroll") for (int _i = 0; _i < 2; ++_i) \
        __builtin_amdgcn_global_load_lds((const unsigned*)((const char*)(gbase) + (voff)[_i]), (PG8_LAS unsigned*)(lds + (bufoff) + ldsw + _i * 8192), 16, 0, 0); } while (0)
#define PG8_LDA(dst, b, h) do { _Pragma("unroll") for (int m = 0; m < 4; ++m) _Pragma("unroll") for (int k = 0; k < 2; ++k) dst[m][k] = *(const PG8_LAS bf16x8*)(lds + PG8_SA(b, h) + aoff + m * 2048 + k * 1024); } while (0)
#define PG8_LDB(dst, b, h) do { _Pragma("unroll") for (int n = 0; n < 2; ++n) _Pragma("unroll") for (int k = 0; k < 2; ++k) dst[n][k] = *(const PG8_LAS bf16x8*)(lds + PG8_SB(b, h) + boff + n * 2048 + k * 1024); } while (0)
#define PG8_MMA(ai, bj, At, Bt) do { __builtin_amdgcn_s_setprio(1); _Pragma("unroll") for (int m = 0; m < 4; ++m) _Pragma("unroll") for (int n = 0; n < 2; ++n) _Pragma("unroll") for (int k = 0; k < 2; ++k) \
        acc[ai][bj][m][n] = __builtin_amdgcn_mfma_f32_16x16x32_bf16(Bt[n][k], At[m][k], acc[ai][bj][m][n], 0, 0, 0); __builtin_amdgcn_s_setprio(0); } while (0)
#define PG8_WAIT_V(n) asm volatile("s_waitcnt vmcnt(" #n ")" ::: "memory")
#define PG8_WAIT_L(n) asm volatile("s_waitcnt lgkmcnt(" #n ")" ::: "memory")
#define PG8_BAR __builtin_amdgcn_s_barrier()
#define PG8_SCHED __builtin_amdgcn_sched_barrier(0)
    Unit cur, nxt; int ui = 0;
    if (!S.next(0, cur)) return;
    f32x4 acc[2][2][4][2];
#pragma unroll
    for (int a = 0; a < 2; ++a)
#pragma unroll
        for (int b = 0; b < 2; ++b)
#pragma unroll
            for (int m = 0; m < 4; ++m)
#pragma unroll
                for (int n = 0; n < 2; ++n) acc[a][b][m][n] = (f32x4){0.f, 0.f, 0.f, 0.f};
    bf16x8 At[4][2], B0[2][2], B1[2][2];
    const char* cA = (const char*)g.A + (size_t)cur.pm * tstep; const char* cB = (const char*)g.Bt + (size_t)cur.pn * tstep;
    S.a_ready(cur);
    if constexpr (SP2) {
        PG8_STAGE(PG8_SB(0, 0), cB, voffB); PG8_STAGE(PG8_SB(0, 1), cB + hstep, voffB); PG8_STAGE(PG8_SA(0, 0), cA, voffA); PG8_STAGE(PG8_SA(0, 1), cA + hstep, voffA);
        if (wr == 1) PG8_BAR;
        PG8_WAIT_V(2); PG8_BAR;
        PG8_STAGE(PG8_SB(1, 0), cB + kstep, voffB); PG8_STAGE(PG8_SA(1, 0), cA + kstep, voffA); PG8_STAGE(PG8_SB(1, 1), cB + hstep + kstep, voffB);
        PG8_WAIT_V(6); PG8_BAR;
    } else {
        PG8_STAGE(PG8_SB(0, 0), cB, voffB); PG8_STAGE(PG8_SA(0, 0), cA, voffA); PG8_STAGE(PG8_SB(0, 1), cB + hstep, voffB); PG8_STAGE(PG8_SA(0, 1), cA + hstep, voffA);
        if (wr == 1) PG8_BAR;
        PG8_WAIT_V(4); PG8_BAR;
        PG8_STAGE(PG8_SB(1, 0), cB + kstep, voffB); PG8_STAGE(PG8_SA(1, 0), cA + kstep, voffA); PG8_STAGE(PG8_SB(1, 1), cB + hstep + kstep, voffB);
        PG8_WAIT_V(6); PG8_BAR;
    }
    for (;;) {
        const bool has_next = S.next(ui + 1, nxt);
        const char* nA = has_next ? (const char*)g.A + (size_t)nxt.pm * tstep : cA; const char* nB = has_next ? (const char*)g.Bt + (size_t)nxt.pn * tstep : cB;
        for (int t = 0; t < nt; t += 2) {
            const bool last = (t == nt - 2);
            const char* a1 = cA + (size_t)(t + 1) * kstep;
            const char* a2 = last ? nA : cA + (size_t)(t + 2) * kstep; const char* b2 = last ? nB : cB + (size_t)(t + 2) * kstep;
            const char* a3 = a2 + kstep; const char* b3 = b2 + kstep;
            if (last && has_next) S.a_ready(nxt);
            if constexpr (SP2) {
            PG8_LDB(B0, 0, 0); PG8_LDB(B1, 0, 1); PG8_SCHED; PG8_LDA(At, 0, 0); PG8_STAGE(PG8_SA(1, 1), a1 + hstep, voffA);
            PG8_WAIT_V(8); PG8_WAIT_L(0); PG8_BAR; PG8_MMA(0, 0, At, B0); PG8_MMA(0, 1, At, B1); PG8_BAR; PG8_SCHED;
            PG8_LDA(At, 0, 1); PG8_STAGE(PG8_SB(0, 0), b2, voffB); PG8_STAGE(PG8_SB(0, 1), b2 + hstep, voffB); PG8_STAGE(PG8_SA(0, 0), a2, voffA);
            PG8_WAIT_V(8); PG8_WAIT_L(0); PG8_BAR; PG8_MMA(1, 0, At, B0); PG8_MMA(1, 1, At, B1); PG8_BAR; PG8_SCHED;
            PG8_LDB(B0, 1, 0); PG8_LDB(B1, 1, 1); PG8_SCHED; PG8_LDA(At, 1, 0); PG8_STAGE(PG8_SA(0, 1), a2 + hstep, voffA);
            PG8_WAIT_V(8); PG8_WAIT_L(0); PG8_BAR; PG8_MMA(0, 0, At, B0); PG8_MMA(0, 1, At, B1); PG8_BAR; PG8_SCHED;
            PG8_LDA(At, 1, 1); PG8_STAGE(PG8_SB(1, 0), b3, voffB); PG8_STAGE(PG8_SB(1, 1), b3 + hstep, voffB); PG8_STAGE(PG8_SA(1, 0), a3, voffA);
            PG8_WAIT_V(8); PG8_WAIT_L(0); PG8_BAR; PG8_MMA(1, 0, At, B0); PG8_MMA(1, 1, At, B1); PG8_BAR; PG8_SCHED;
            } else {
            PG8_LDB(B0, 0, 0); PG8_SCHED; PG8_LDA(At, 0, 0); PG8_STAGE(PG8_SA(1, 1), a1 + hstep, voffA);
            PG8_WAIT_L(8); PG8_BAR; PG8_WAIT_L(0); PG8_MMA(0, 0, At, B0); PG8_BAR; PG8_SCHED;
            PG8_LDB(B1, 0, 1); PG8_STAGE(PG8_SB(0, 0), b2, voffB);
            PG8_BAR; PG8_WAIT_L(0); PG8_MMA(0, 1, At, B1); PG8_BAR;
            PG8_LDA(At, 0, 1); PG8_STAGE(PG8_SA(0, 0), a2, voffA);
            PG8_BAR; PG8_WAIT_L(0); PG8_MMA(1, 0, At, B0); PG8_BAR; PG8_SCHED;
            PG8_STAGE(PG8_SB(0, 1), b2 + hstep, voffB);
            PG8_WAIT_V(6); PG8_BAR; PG8_MMA(1, 1, At, B1); PG8_BAR;
            PG8_LDB(B0, 1, 0); PG8_SCHED; PG8_LDA(At, 1, 0); PG8_STAGE(PG8_SA(0, 1), a2 + hstep, voffA);
            PG8_WAIT_L(8); PG8_BAR; PG8_WAIT_L(0); PG8_MMA(0, 0, At, B0); PG8_BAR; PG8_SCHED;
            PG8_LDB(B1, 1, 1); PG8_STAGE(PG8_SB(1, 0), b3, voffB);
            PG8_BAR; PG8_WAIT_L(0); PG8_MMA(0, 1, At, B1); PG8_BAR;
            PG8_LDA(At, 1, 1); PG8_STAGE(PG8_SA(1, 0), a3, voffA);
            PG8_BAR; PG8_WAIT_L(0); PG8_MMA(1, 0, At, B0); PG8_BAR; PG8_SCHED;
            PG8_STAGE(PG8_SB(1, 1), b3 + hstep, voffB);
            PG8_WAIT_V(6); PG8_BAR; PG8_MMA(1, 1, At, B1); PG8_BAR;
            }
        }
        if constexpr (ALIGN_EPI) { if (wr == 0) PG8_BAR; }
        if constexpr (!Epi::AFTER_DRAIN) { E(acc, cur, wr, wc, fr, fq); S.done(cur); }
        if (!has_next) break;
#pragma unroll
        for (int a = 0; a < 2; ++a)
#pragma unroll
            for (int b = 0; b < 2; ++b)
#pragma unroll
                for (int m = 0; m < 4; ++m)
#pragma unroll
                    for (int n = 0; n < 2; ++n) acc[a][b][m][n] = (f32x4){0.f, 0.f, 0.f, 0.f};
        cur = nxt; cA = nA; cB = nB; ++ui;
        if constexpr (ALIGN_EPI) { if (wr == 1) PG8_BAR; }
    }
    PG8_WAIT_V(0);
    if constexpr (!ALIGN_EPI) { if (wr == 0) PG8_BAR; }
    PG8_BAR;
    if constexpr (Epi::AFTER_DRAIN) { E.fused(acc, cur, wr, wc, fr, fq, lds, wid, lane); S.done(cur); }
#undef PG8_SA
#undef PG8_SB
#undef PG8_STAGE
#undef PG8_LDA
#undef PG8_LDB
#undef PG8_MMA
#undef PG8_WAIT_V
#undef PG8_WAIT_L
#undef PG8_BAR
#undef PG8_SCHED
}
}

#ifndef PG8_SP2
#define PG8_SP2 true
#endif
#ifndef PG8_ALIGN
#define PG8_ALIGN true
#endif
namespace pg8 {
constexpr float kLog2e = 1.4426950408889634f;
__device__ __forceinline__ float sigmoid_f(float x) { return __builtin_amdgcn_rcpf(1.0f + __builtin_amdgcn_exp2f(-kLog2e * x)); }
typedef unsigned u32x2 __attribute__((ext_vector_type(2)));

struct EpiIn {
    static constexpr bool PERM = true, AFTER_DRAIN = false;
    bf16_t *Q, *K, *V, *GB, *U, *VA, *GA; const float *qn, *kn; const int* pos; float qscale;
    __device__ __forceinline__ void operator()(const f32x4 (&acc)[2][2][4][2], const Unit& u, int wr, int wc, int fr, int fq) const {
        const int pn = u.pn;
        const int row0 = u.pm * BM + wr * 64 + fr;
        if (pn < 4) {
            const bool isq = pn < 2;
            const int head = (pn & 1) * 4 + wc;
            const float* gs = isq ? qn : kn; bf16_t* dst = isq ? Q : K; const float sc = isq ? qscale : 1.0f;
            f32x4 g[2][2], invf[2];
#pragma unroll
            for (int bj = 0; bj < 2; ++bj)
#pragma unroll
                for (int n = 0; n < 2; ++n) g[bj][n] = *(const f32x4*)(gs + 32 * bj + 8 * fq + 4 * n);
#pragma unroll
            for (int n = 0; n < 2; ++n)
#pragma unroll
                for (int e = 0; e < 4; ++e) invf[n][e] = __builtin_amdgcn_exp2f(-(float)(8 * fq + 4 * n + e) * 0.41524101186092f) * 0.15915494309189535f;
#pragma unroll
            for (int ai = 0; ai < 2; ++ai)
#pragma unroll
                for (int m = 0; m < 4; ++m) {
                    const int row = row0 + ai * HALF + m * 16;
                    const float p = (float)pos[row];
                    float ss = 0.f;
#pragma unroll
                    for (int bj = 0; bj < 2; ++bj)
#pragma unroll
                        for (int n = 0; n < 2; ++n) { const f32x4 v = acc[ai][bj][m][n]; ss += (v[0] * v[0] + v[1] * v[1]) + (v[2] * v[2] + v[3] * v[3]); }
                    ss += __shfl_xor(ss, 16); ss += __shfl_xor(ss, 32);
                    const float rstd = __builtin_amdgcn_rsqf(ss * (1.0f / 64.0f) + 1e-6f) * sc;
                    u32x4 w0, w1;
#pragma unroll
                    for (int n = 0; n < 2; ++n) {
                        const f32x4 y0 = acc[ai][0][m][n] * rstd * g[0][n], y1 = acc[ai][1][m][n] * rstd * g[1][n];
                        f32x4 o0, o1;
#pragma unroll
                        for (int e = 0; e < 4; ++e) {
                            float rev = p * invf[n][e]; rev = __builtin_amdgcn_fractf(rev);
                            const float c = __builtin_amdgcn_cosf(rev), s = __builtin_amdgcn_sinf(rev);
                            o0[e] = y0[e] * c - y1[e] * s; o1[e] = y1[e] * c + y0[e] * s;
                        }
                        w0[2 * n] = cvt_pk_bf16(o0[0], o0[1]); w0[2 * n + 1] = cvt_pk_bf16(o0[2], o0[3]);
                        w1[2 * n] = cvt_pk_bf16(o1[0], o1[1]); w1[2 * n + 1] = cvt_pk_bf16(o1[2], o1[3]);
                    }
                    const int b = row >> 13, s = row & 8191;
                    bf16_t* rp = dst + ((size_t)((b * 8 + head) * 8192 + s)) * 64 + 8 * fq;
                    *(u32x4*)rp = w0; *(u32x4*)(rp + 32) = w1;
                }
        } else {
            const int sec = (pn - 4) >> 1;
            const int cbase = ((pn - 4) & 1) * 256 + wc * 32 + 8 * fq;
            bf16_t* base = sec == 1 ? GB : sec == 2 ? U : sec == 3 ? VA : GA;
#pragma unroll
            for (int ai = 0; ai < 2; ++ai)
#pragma unroll
                for (int m = 0; m < 4; ++m) {
                    const int row = row0 + ai * HALF + m * 16;
#pragma unroll
                    for (int bj = 0; bj < 2; ++bj) {
                        const f32x4 v0 = acc[ai][bj][m][0], v1 = acc[ai][bj][m][1];
                        u32x4 w; w.x = cvt_pk_bf16(v0[0], v0[1]); w.y = cvt_pk_bf16(v0[2], v0[3]); w.z = cvt_pk_bf16(v1[0], v1[1]); w.w = cvt_pk_bf16(v1[2], v1[3]);
                        const int col = cbase + bj * HALF;
                        if (sec == 0) { const int b = row >> 13, s = row & 8191, head = col >> 6, d = col & 63; *(u32x4*)(V + ((size_t)((b * 8 + head) * 8192 + s)) * 64 + d) = w; }
                        else *(u32x4*)(base + (size_t)row * 512 + col) = w;
                    }
                }
        }
    }
};
struct EpiOut {
    static constexpr bool PERM = false, AFTER_DRAIN = false;
    const float* x; bf16_t* hb; float* ss;
    __device__ __forceinline__ void operator()(const f32x4 (&acc)[2][2][4][2], const Unit& u, int wr, int wc, int fr, int fq) const {
        const int row0 = u.pm * BM + wr * 64 + fr, col0 = u.pn * BM + wc * 32 + 4 * fq;
#pragma unroll
        for (int ai = 0; ai < 2; ++ai) {
            f32x4 xv[4][2][2];
#pragma unroll
            for (int m = 0; m < 4; ++m)
#pragma unroll
                for (int bj = 0; bj < 2; ++bj)
#pragma unroll
                    for (int n = 0; n < 2; ++n) xv[m][bj][n] = *(const f32x4*)(x + (size_t)(row0 + ai * HALF + m * 16) * 1024 + col0 + bj * HALF + n * 16);
#pragma unroll
            for (int m = 0; m < 4; ++m) {
                const int row = row0 + ai * HALF + m * 16; float q = 0.f;
#pragma unroll
                for (int bj = 0; bj < 2; ++bj)
#pragma unroll
                    for (int n = 0; n < 2; ++n) {
                        const size_t off = (size_t)row * 1024 + col0 + bj * HALF + n * 16;
                        const f32x4 h = xv[m][bj][n] + acc[ai][bj][m][n];
                        q += (h[0] * h[0] + h[1] * h[1]) + (h[2] * h[2] + h[3] * h[3]);
                        u32x2 w; w.x = cvt_pk_bf16(h[0], h[1]); w.y = cvt_pk_bf16(h[2], h[3]);
                        *(u32x2*)(hb + off) = w;
                    }
                q += __shfl_xor(q, 16); q += __shfl_xor(q, 32);
                if (fq == 0) atomicAdd(ss + row, q);
            }
            asm volatile("" ::: "memory");
        }
    }
};
struct EpiFinal {
    static constexpr bool PERM = false, AFTER_DRAIN = false;
    const bf16_t* hb; float* out; const bf16_t* proj; const float* ss; const float* bg;
    __device__ __forceinline__ void operator()(const f32x4 (&acc)[2][2][4][2], const Unit& u, int wr, int wc, int fr, int fq) const {
        const int row0 = u.pm * BM + wr * 64 + fr, col0 = u.pn * BM + wc * 32 + 4 * fq;
        f32x4 bv[2][2];
#pragma unroll
        for (int bj = 0; bj < 2; ++bj)
#pragma unroll
            for (int n = 0; n < 2; ++n) bv[bj][n] = *(const f32x4*)(bg + col0 + bj * HALF + n * 16);
#pragma unroll
        for (int ai = 0; ai < 2; ++ai) {
            u32x2 hw[4][2][2], pw[4][2][2]; float sv[4];
#pragma unroll
            for (int m = 0; m < 4; ++m) {
                const int row = row0 + ai * HALF + m * 16; sv[m] = ss[row];
#pragma unroll
                for (int bj = 0; bj < 2; ++bj)
#pragma unroll
                    for (int n = 0; n < 2; ++n) { const size_t off = (size_t)row * 1024 + col0 + bj * HALF + n * 16; hw[m][bj][n] = *(const u32x2*)(hb + off); pw[m][bj][n] = *(const u32x2*)(proj + off); }
            }
#pragma unroll
            for (int m = 0; m < 4; ++m) {
                const int row = row0 + ai * HALF + m * 16;
                const float rstd = __builtin_amdgcn_rsqf(sv[m] * (1.0f / 1024.0f) + 1e-6f);
#pragma unroll
                for (int bj = 0; bj < 2; ++bj)
#pragma unroll
                    for (int n = 0; n < 2; ++n) {
                        const size_t off = (size_t)row * 1024 + col0 + bj * HALF + n * 16;
                        const f32x4 a = acc[ai][bj][m][n] * rstd + bv[bj][n];
                        const u32x2 h2 = hw[m][bj][n], p2 = pw[m][bj][n];
                        f32x4 o;
                        o[0] = __uint_as_float(h2.x << 16) + sigmoid_f(a[0]) * __uint_as_float(p2.x << 16);
                        o[1] = __uint_as_float(h2.x & 0xffff0000u) + sigmoid_f(a[1]) * __uint_as_float(p2.x & 0xffff0000u);
                        o[2] = __uint_as_float(h2.y << 16) + sigmoid_f(a[2]) * __uint_as_float(p2.y << 16);
                        o[3] = __uint_as_float(h2.y & 0xffff0000u) + sigmoid_f(a[3]) * __uint_as_float(p2.y & 0xffff0000u);
                        *(f32x4*)(out + off) = o;
                    }
            }
            asm volatile("" ::: "memory");
        }
    }
};
}
#define GAS __attribute__((address_space(1)))
#define LAS __attribute__((address_space(3)))
typedef unsigned short bf16;
typedef unsigned v4u __attribute__((ext_vector_type(4)));
typedef float f32x4 __attribute__((ext_vector_type(4)));
typedef short bf16x8 __attribute__((ext_vector_type(8)));
typedef GAS unsigned gu32;
typedef GAS unsigned long long gu64;
#define RLX_AGENT __ATOMIC_RELAXED, __HIP_MEMORY_SCOPE_AGENT
#define LDS_WAIT() asm volatile("s_waitcnt lgkmcnt(0)" ::: "memory")
#define VM_WAIT() asm volatile("s_waitcnt vmcnt(0)" ::: "memory")
__device__ __forceinline__ unsigned long long rt() { return __builtin_amdgcn_s_memrealtime(); }
__device__ __forceinline__ unsigned f2bf(float f) { unsigned u = __builtin_bit_cast(unsigned, f); return (u + 0x7fffu + ((u >> 16) & 1u)) >> 16; }
__device__ __forceinline__ unsigned pk2(float lo, float hi) { return f2bf(lo) | (f2bf(hi) << 16); }

#define XB_TMO      128
#define XB_XCNT(j)  (256  + 64 * (j))
#define XB_XSUB(j)  (1280 + 64 * (j))
#define XB_XGEN(j)  (2304 + 64 * (j))
#define XB_TOP      3328
#define XB_TOPGEN   3392
#define XCD_BAR_WORDS 3456
#define XB_SPIN_CAP (1u << 18)

__device__ __forceinline__ unsigned xb_ld(unsigned* p)              { return __hip_atomic_load(p, __ATOMIC_RELAXED, __HIP_MEMORY_SCOPE_AGENT); }
__device__ __forceinline__ unsigned xb_add(unsigned* p, unsigned v) { return __hip_atomic_fetch_add(p, v, __ATOMIC_RELAXED, __HIP_MEMORY_SCOPE_AGENT); }
__device__ __forceinline__ unsigned xb_xcc_id() { return (unsigned)__builtin_amdgcn_s_getreg((3 << 11) | 20) & 0xFu; }
#define XB_SPIN(cond, bar) do { unsigned _sp = 0; while (cond) { __builtin_amdgcn_s_sleep(1); \
    if ((++_sp & 255u) == 0u) { if (xb_ld(&(bar)[XB_TMO])) break; if (_sp > XB_SPIN_CAP) { atomicAdd(&(bar)[XB_TMO], 1u); break; } } } } while (0)

struct XcdBarrier {
    unsigned* bar; unsigned x;
    volatile LAS unsigned* st;
};

__device__ __forceinline__ XcdBarrier xcd_barrier_post(unsigned* bar, volatile LAS unsigned* st) {
    XcdBarrier b; b.bar = bar; b.x = xb_xcc_id(); b.st = st;
    if (threadIdx.x == 0) (void)xb_add(&bar[XB_XCNT(b.x)], 1u);
    return b;
}
__device__ __forceinline__ void xcd_barrier_complete(unsigned* bar, unsigned x, unsigned& nloc, unsigned& nx) {
    const unsigned G = gridDim.x * gridDim.y * gridDim.z;
    unsigned sum, cnt, mine, sp = 0u;
    for (;;) {
        sum = 0u; cnt = 0u; mine = 0u;
#pragma unroll
        for (unsigned j = 0; j < 16; ++j) { const unsigned c = xb_ld(&bar[XB_XCNT(j)]); sum += c; cnt += (c > 0u) ? 1u : 0u; mine = (j == x) ? c : mine; }
        if (sum == G) break;
        __builtin_amdgcn_s_sleep(1);
        if ((++sp & 255u) == 0u) { if (xb_ld(&bar[XB_TMO])) break; if (sp > XB_SPIN_CAP) { atomicAdd(&bar[XB_TMO], 1u); break; } }
    }
    nloc = mine > 0u ? mine : 1u; nx = cnt > 0u ? cnt : 1u;
}

__device__ __forceinline__ void xcd_barrier(const XcdBarrier& b) {
    asm volatile("s_waitcnt vmcnt(0)" ::: "memory");
    __syncthreads();
    if (threadIdx.x == 0) {
        unsigned* bar = b.bar;
        __builtin_amdgcn_s_waitcnt(0);
        unsigned nloc = b.st[0], nx = b.st[1];
        if (nloc == 0u) { xcd_barrier_complete(bar, b.x, nloc, nx); b.st[0] = nloc; b.st[1] = nx; }
        const unsigned old = xb_add(&bar[XB_XSUB(b.x)], 1u);
        const unsigned gen = old / nloc;
        if (old + 1u == (gen + 1u) * nloc) {
            __builtin_amdgcn_fence(__ATOMIC_RELEASE, "agent");
            asm volatile("s_waitcnt vmcnt(0)" ::: "memory");
            const unsigned og = xb_add(&bar[XB_TOP], 1u);
            const unsigned tg = og / nx;
            if (og + 1u == (tg + 1u) * nx) xb_add(&bar[XB_TOPGEN], 1u);
            else XB_SPIN(xb_ld(&bar[XB_TOPGEN]) == tg, bar);
            __builtin_amdgcn_fence(__ATOMIC_ACQUIRE, "agent");
            xb_add(&bar[XB_XGEN(b.x)], 1u);
            asm volatile("s_waitcnt vmcnt(0)" ::: "memory");
        } else {
            XB_SPIN(xb_ld(&bar[XB_XGEN(b.x)]) == gen, bar);
            __builtin_amdgcn_fence(__ATOMIC_ACQUIRE, "agent");
            asm volatile("s_waitcnt vmcnt(0)" ::: "memory");
        }
    }
    __syncthreads();
}
constexpr int NWAVES = 8;
#ifndef MK_PLAN
#define MK_PLAN 0
#endif
constexpr int PLAN = MK_PLAN;
constexpr int NPHASE = 7;

constexpr int BATCH = 4, SEQ = 8192, DM = 1024, NH = 8, HD = 64, AW = 512, GW = 512, INC = 3584, PLE = 256;
constexpr int M = BATCH * SEQ;
constexpr float EPS = 1e-6f;

constexpr size_t MiB = 1u << 20;
constexpr size_t WS_CTL = 0, CTL_ZERO_BYTES = 1 * MiB;
constexpr size_t WS_WIN = 2 * MiB;
constexpr size_t WS_WOUT = 10 * MiB;
constexpr size_t WS_WG = 12 * MiB;
constexpr size_t WS_WP = 14 * MiB;
constexpr size_t WS_WSP = 15 * MiB;
constexpr size_t WS_SS = 512 * 1024;
constexpr size_t WS_DEN4 = 16 * MiB, WS_DEN16 = 17 * MiB;
constexpr size_t WS_PB = 18 * MiB;
constexpr size_t WS_A = 34 * MiB;
constexpr size_t WS_MIXED = WS_A;
constexpr size_t WS_Q = 98 * MiB, WS_K = 130 * MiB, WS_V = 162 * MiB;
constexpr size_t WS_HB = WS_Q;
constexpr size_t WS_GB = 194 * MiB, WS_U = 226 * MiB, WS_VA = 258 * MiB, WS_GA = 290 * MiB;
constexpr size_t WS_PROJ = WS_GB;
constexpr size_t WS_P4 = 322 * MiB, WS_P16 = 354 * MiB;
constexpr size_t WS_END = 386 * MiB;
constexpr int CW_BAR = 4096;

constexpr int RING_OFF = 0, RING_BYTES = 151552;
constexpr int LDSCTL_OFF = RING_BYTES, MISC_OFF = LDSCTL_OFF + 320;
constexpr int LDS_BYTES = 155648;
static_assert(MISC_OFF + 128 <= LDS_BYTES, "LDS map");

__device__ __forceinline__ float wave_sum(float v) {
#pragma unroll
    for (int o = 1; o < 64; o <<= 1) v += __shfl_xor(v, o);
    return v;
}
__device__ __forceinline__ float wave_max(float v) {
#pragma unroll
    for (int o = 1; o < 64; o <<= 1) v = fmaxf(v, __shfl_xor(v, o));
    return v;
}
__device__ __forceinline__ float bflo(unsigned w) { return __uint_as_float(w << 16); }
__device__ __forceinline__ float bfhi(unsigned w) { return __uint_as_float(w & 0xffff0000u); }
template <bool QKPERM> __device__ __forceinline__ void p0_transpose_item(const float* W, int K, int N, bf16* WT, const float* kscale, LAS float* scr, int item, int lane) {
    const int nblk = N / 32, kb = item / nblk, nb = item % nblk, k0 = 64 * kb, n0 = 32 * nb;
#pragma unroll 8
    for (int i = 0; i < 32; ++i) { const int kk = 2 * i + (lane >> 5); float v = W[(size_t)(k0 + kk) * N + n0 + (lane & 31)]; if (kscale) v *= kscale[k0 + kk]; scr[kk * 33 + (lane & 31)] = v; }
    LDS_WAIT(); asm volatile("" ::: "memory");
    int r0 = n0;
    if (QKPERM && n0 < 1024) { const int pn = n0 >> 8, w = n0 & 255; r0 = pn * 256 + ((w >> 5) & 1) * 128 + (w >> 6) * 32; }
    const int c = lane & 7;
#pragma unroll
    for (int j = 0; j < 4; ++j) { const int n = (lane >> 3) + 8 * j; const LAS float* s = scr + (8 * c) * 33 + n;
        v4u o; o.x = pk2(s[0 * 33], s[1 * 33]); o.y = pk2(s[2 * 33], s[3 * 33]); o.z = pk2(s[4 * 33], s[5 * 33]); o.w = pk2(s[6 * 33], s[7 * 33]);
        *(GAS v4u*)(WT + (size_t)(r0 + n) * K + k0 + 8 * c) = o; }
    LDS_WAIT(); asm volatile("" ::: "memory");
}

namespace att {
typedef short bf16x8 __attribute__((ext_vector_type(8)));
typedef short v4i16 __attribute__((ext_vector_type(4)));
typedef float f32x16 __attribute__((ext_vector_type(16)));
typedef unsigned u32x4 __attribute__((ext_vector_type(4)));
typedef unsigned u32x2 __attribute__((ext_vector_type(2)));
constexpr int KOFF = 0, VOFF = 384 * 128, STG = 2 * 384 * 128, STG_ROW = 144, STG_W = 32 * STG_ROW, DSC = STG + 8 * STG_W, ATT_LDS = DSC + 8 * 32 * 4;
static_assert(ATT_LDS <= RING_BYTES, "attention LDS");
__device__ __forceinline__ int crow(int r, int hi) { return (r & 3) + 8 * (r >> 2) + 4 * hi; }
typedef float f32x2_t __attribute__((ext_vector_type(2))); typedef __bf16 bf16x2_t __attribute__((ext_vector_type(2)));
__device__ __forceinline__ unsigned cvtpk(float lo, float hi) { f32x2_t v = {lo, hi}; bf16x2_t b = __builtin_convertvector(v, bf16x2_t); return __builtin_bit_cast(unsigned, b); }
struct Tens { const bf16 *Q, *K, *V; bf16 *P4, *P16; float *D4, *D16; const bf16* GB; bf16* MIXED; };
struct Unit { int R, b, h, res, blk; };
struct Pre { u32x4 kv[6], vv[6]; bf16x8 qf[4]; };

__device__ __forceinline__ void unit_load(Pre& P, const Tens& T, const Unit& u, int tid, int wid, int r32, int hi) {
    const size_t hb = (size_t)(u.b * NH + u.h) * SEQ * HD;
    const int l0 = u.blk * 256, ch = tid & 7;
#pragma unroll
    for (int i = 0; i < 6; ++i) {
        const int row = (tid >> 3) + 64 * i, l = l0 - 128 + row;
        if (l >= 0) { const size_t off = hb + (size_t)(l * u.R + u.res) * HD + ch * 8; P.kv[i] = *(const GAS u32x4*)(T.K + off); P.vv[i] = *(const GAS u32x4*)(T.V + off); }
        else { P.kv[i] = (u32x4){0u, 0u, 0u, 0u}; P.vv[i] = (u32x4){0u, 0u, 0u, 0u}; }
    }
    const size_t qoff = hb + (size_t)((l0 + 32 * wid + r32) * u.R + u.res) * HD + 8 * hi;
#pragma unroll
    for (int ks = 0; ks < 4; ++ks) P.qf[ks] = *(const GAS bf16x8*)(T.Q + qoff + 16 * ks);
}
__device__ __forceinline__ void unit_stage(const Pre& P, LAS unsigned char* lds, int tid) {
    const int ch = tid & 7;
#pragma unroll
    for (int i = 0; i < 6; ++i) {
        const int row = (tid >> 3) + 64 * i;
        *(LAS u32x4*)(lds + KOFF + row * 128 + ((ch ^ ((row >> 1) & 7)) << 4)) = P.kv[i];
        *(LAS u32x4*)(lds + VOFF + row * 128 + ((ch ^ (((row >> 1) & 1) << 2)) << 4)) = P.vv[i];
    }
}
#define ATT_SB() __builtin_amdgcn_sched_barrier(0)
__device__ __forceinline__ float silu_f(float x) { return x * __builtin_amdgcn_rcpf(1.0f + __builtin_amdgcn_exp2f(-1.4426950408889634f * x)); }
template <bool MERGE> __device__ __forceinline__ void unit_compute(const bf16x8 (&qf)[4], LAS unsigned char* lds, const Tens& T, const Unit& u, float negM, int lane, int wid, int r32, int hi) {
    f32x16 oT[2]; float dsum = 0.f;
#pragma unroll
    for (int r = 0; r < 16; ++r) { oT[0][r] = 0.f; oT[1][r] = 0.f; }
    const int q4 = (lane & 15) >> 2, p4 = lane & 3, g1 = (lane >> 4) & 1;
    const int j0 = (u.blk == 0) ? ((4 - wid) > 0 ? (4 - wid) : 0) : 0;
    bf16x8 kf[4];
    {   const int krow = 32 * (wid + j0) + r32, ksw = (krow >> 1) & 7; const LAS unsigned char* kp = lds + KOFF + krow * 128;
#pragma unroll
        for (int ks = 0; ks < 4; ++ks) kf[ks] = *(const LAS bf16x8*)(kp + (((2 * ks + hi) ^ ksw) << 4)); }
#pragma unroll 1
    for (int j = j0; j < 5; ++j) {
        const int rb = 32 * (wid + j);
        f32x16 p;
#pragma unroll
        for (int r = 0; r < 16; ++r) p[r] = negM;
#pragma unroll
        for (int ks = 0; ks < 4; ++ks) p = __builtin_amdgcn_mfma_f32_32x32x16_bf16(kf[ks], qf[ks], p, 0, 0, 0);
        ATT_SB();
        v4i16 vlo[2][2], vhh[2][2];
#pragma unroll
        for (int s = 0; s < 2; ++s)
#pragma unroll
            for (int db = 0; db < 2; ++db) {
                const int vrow = rb + 16 * s + 4 * hi + q4, chn = 4 * db + 2 * g1 + (p4 >> 1);
                const LAS unsigned char* vp = lds + VOFF + vrow * 128 + ((chn ^ (((vrow >> 1) & 1) << 2)) << 4) + 8 * (p4 & 1);
                vlo[s][db] = __builtin_amdgcn_ds_read_tr16_b64_v4i16((LAS v4i16*)vp);
                vhh[s][db] = __builtin_amdgcn_ds_read_tr16_b64_v4i16((LAS v4i16*)(vp + 1024));
            }
        if (j < 4) { const int krow = rb + 32 + r32, ksw = (krow >> 1) & 7; const LAS unsigned char* kp = lds + KOFF + krow * 128;
#pragma unroll
            for (int ks = 0; ks < 4; ++ks) kf[ks] = *(const LAS bf16x8*)(kp + (((2 * ks + hi) ^ ksw) << 4)); }
        ATT_SB();
        if (j == 0) {
#pragma unroll
            for (int r = 0; r < 16; ++r) if (crow(r, hi) < r32) p[r] = -INFINITY;
        }
        if (j == 4) {
#pragma unroll
            for (int r = 0; r < 16; ++r) if (crow(r, hi) > r32) p[r] = -INFINITY;
        }
        float ds0 = 0.f, ds1 = 0.f;
#pragma unroll
        for (int r = 0; r < 16; r += 2) { p[r] = __builtin_amdgcn_exp2f(p[r]); p[r + 1] = __builtin_amdgcn_exp2f(p[r + 1]); ds0 += p[r]; ds1 += p[r + 1]; }
        dsum += ds0 + ds1;
        bf16x8 pa[2];
#pragma unroll
        for (int s = 0; s < 2; ++s) { u32x4 w; w.x = cvtpk(p[8 * s + 0], p[8 * s + 1]); w.y = cvtpk(p[8 * s + 2], p[8 * s + 3]); w.z = cvtpk(p[8 * s + 4], p[8 * s + 5]); w.w = cvtpk(p[8 * s + 6], p[8 * s + 7]); pa[s] = __builtin_bit_cast(bf16x8, w); }
        ATT_SB();
#pragma unroll
        for (int s = 0; s < 2; ++s)
#pragma unroll
            for (int db = 0; db < 2; ++db) {
                const bf16x8 vf = (bf16x8){vlo[s][db][0], vlo[s][db][1], vlo[s][db][2], vlo[s][db][3], vhh[s][db][0], vhh[s][db][1], vhh[s][db][2], vhh[s][db][3]};
                oT[db] = __builtin_amdgcn_mfma_f32_32x32x16_bf16(vf, pa[s], oT[db], 0, 0, 0);
            }
        ATT_SB();
    }
    const float dtot = dsum + __shfl_xor(dsum, 32);
    LAS unsigned char* stg = lds + STG + wid * STG_W;
    LAS float* dsc = (LAS float*)(lds + DSC) + wid * 32;
    const int l0 = u.blk * 256;
    u32x4 pa4[4], pa16[4], gg[4]; float d4[4], d16[4];
    if (MERGE) {
#pragma unroll
        for (int i = 0; i < 4; ++i) {
            const int row = (lane >> 3) + 8 * i, ch = lane & 7;
            const size_t grow = (size_t)u.b * SEQ + (size_t)((l0 + 32 * wid + row) * u.R + u.res);
            const size_t poff = grow * AW + u.h * HD + ch * 8;
            pa4[i] = *(const GAS u32x4*)(T.P4 + poff); pa16[i] = *(const GAS u32x4*)(T.P16 + poff); gg[i] = *(const GAS u32x4*)(T.GB + poff);
            d4[i] = T.D4[grow * NH + u.h]; d16[i] = T.D16[grow * NH + u.h];
        }
    }
#pragma unroll
    for (int db = 0; db < 2; ++db)
#pragma unroll
        for (int r4 = 0; r4 < 4; ++r4) { u32x2 w; w.x = cvtpk(oT[db][4 * r4 + 0], oT[db][4 * r4 + 1]); w.y = cvtpk(oT[db][4 * r4 + 2], oT[db][4 * r4 + 3]);
            *(LAS u32x2*)(stg + r32 * STG_ROW + (32 * db + 8 * r4 + 4 * hi) * 2) = w; }
    const size_t growq = (size_t)u.b * SEQ + (size_t)((l0 + 32 * wid + r32) * u.R + u.res);
    if (MERGE) { if (hi == 0) dsc[r32] = dtot; }
    else { if (hi == 0) { float* D = (u.R == 4) ? T.D4 : T.D16; D[growq * NH + u.h] = dtot; } }
    asm volatile("s_waitcnt lgkmcnt(0)" ::: "memory");
#pragma unroll
    for (int i = 0; i < 4; ++i) {
        const int row = (lane >> 3) + 8 * i, ch = lane & 7;
        const u32x4 v = *(const LAS u32x4*)(stg + row * STG_ROW + ch * 16);
        const size_t grow = (size_t)u.b * SEQ + (size_t)((l0 + 32 * wid + row) * u.R + u.res);
        const size_t poff = grow * AW + u.h * HD + ch * 8;
        if (!MERGE) { bf16* Pd = (u.R == 4) ? T.P4 : T.P16; *(GAS u32x4*)(Pd + poff) = v; }
        else {
            const u32x4 a = pa4[i], c = pa16[i], g = gg[i];
            const float d = dsc[row] + d4[i] + d16[i];
            const float inv = 1.0f / d;
            u32x4 o;
#pragma unroll
            for (int e = 0; e < 4; ++e) {
                const float x0 = (bflo(v[e]) + bflo(a[e]) + bflo(c[e])) * inv * silu_f(bflo(g[e]));
                const float x1 = (bfhi(v[e]) + bfhi(a[e]) + bfhi(c[e])) * inv * silu_f(bfhi(g[e]));
                o[e] = cvtpk(x0, x1);
            }
            *(GAS u32x4*)(T.MIXED + grow * DM + u.h * HD + ch * 8) = o;
        }
    }
}
__device__ __forceinline__ Unit unit_of(int idx, bool merge) {
    Unit u;
    if (merge) { u.R = 1; const int bh = idx >> 5; u.b = bh >> 3; u.h = bh & 7; u.res = 0; u.blk = idx & 31; }
    else { const int br = idx >> 10, w = idx & 1023, bh = w >> 5, rb = w & 31; u.b = bh >> 3; u.h = bh & 7;
        if (br == 0) { u.R = 16; u.res = rb >> 1; u.blk = rb & 1; } else { u.R = 4; u.res = rb >> 3; u.blk = rb & 7; } }
    return u;
}
template <bool MERGE> __device__ __forceinline__ void attn_phase(LAS unsigned char* lds, const Tens& T, int vcu, int G, const float* qn, const float* kn) {
    const int tid = threadIdx.x, lane = tid & 63, r32 = lane & 31, hi = lane >> 5, wid = __builtin_amdgcn_readfirstlane(tid >> 6);
    const int total = MERGE ? 1024 : 2048;
    const float mq = wave_max(fabsf(qn[lane])), mk = wave_max(fabsf(kn[lane]));
    const float negM = -8.0f * mq * mk * 1.4426950408889634f;
    Pre P;
    int idx = vcu;
    if (idx < total) { const Unit u = unit_of(idx, MERGE); unit_load(P, T, u, tid, wid, r32, hi); }
    for (; idx < total; idx += G) {
        const Unit u = unit_of(idx, MERGE);
        unit_stage(P, lds, tid);
        bf16x8 qf[4];
#pragma unroll
        for (int ks = 0; ks < 4; ++ks) qf[ks] = P.qf[ks];
        __syncthreads();
        if (idx + G < total) { const Unit un = unit_of(idx + G, MERGE); unit_load(P, T, un, tid, wid, r32, hi); }
        unit_compute<MERGE>(qf, lds, T, u, negM, lane, wid, r32, hi);
        __syncthreads();
    }
}
}

namespace gm {
typedef short bf16x8 __attribute__((ext_vector_type(8)));
typedef short v4i16 __attribute__((ext_vector_type(4)));
typedef float f32x16 __attribute__((ext_vector_type(16)));
typedef unsigned u32x4 __attribute__((ext_vector_type(4)));
typedef unsigned u32x2 __attribute__((ext_vector_type(2)));
constexpr int GSTG = 131072, GSTG_ROW = 80, GSTG_W = 32 * GSTG_ROW, GM_LDS = GSTG + 8 * GSTG_W;
static_assert(GM_LDS <= RING_BYTES, "gMLP LDS");
__device__ __forceinline__ float sig_f(float x) { return __builtin_amdgcn_rcpf(1.0f + __builtin_amdgcn_exp2f(-1.4426950408889634f * x)); }
__device__ __forceinline__ float gelu_f(float x) { return x * sig_f(x * (1.5957691216f + 0.0713548163f * x * x)); }
__device__ __forceinline__ float silu_f(float x) { return x * sig_f(x); }
__device__ __forceinline__ void gmlp_unit(LAS unsigned char* lds, int uc, const bf16* VA, const bf16* U, const bf16* GA, const bf16* WSb, const float* bs, const float* lng, const float* lnb, bf16* MIXED) {
    const int tid = threadIdx.x, lane = tid & 63, r32 = lane & 31, hi = lane >> 5, wid = __builtin_amdgcn_readfirstlane(tid >> 6);
    const size_t T0 = (size_t)uc * 128;
    float lg[8], lb[8];
#pragma unroll
    for (int e = 0; e < 8; ++e) { lg[e] = lng[lane * 8 + e]; lb[e] = lnb[lane * 8 + e]; }
#pragma unroll 1
    for (int rq = 0; rq < 4; ++rq) {
        u32x4 w[4];
#pragma unroll
        for (int k = 0; k < 4; ++k) w[k] = *(const GAS u32x4*)(VA + (T0 + 16 * wid + 4 * rq + k) * GW + lane * 8);
        float v[4][8], s[4];
#pragma unroll
        for (int k = 0; k < 4; ++k) { s[k] = 0.f;
#pragma unroll
            for (int e = 0; e < 4; ++e) { v[k][2 * e] = gelu_f(bflo(w[k][e])); v[k][2 * e + 1] = gelu_f(bfhi(w[k][e])); s[k] += v[k][2 * e] + v[k][2 * e + 1]; } }
#pragma unroll
        for (int o = 1; o < 64; o <<= 1) {
#pragma unroll
            for (int k = 0; k < 4; ++k) s[k] += __shfl_xor(s[k], o); }
        float q[4];
#pragma unroll
        for (int k = 0; k < 4; ++k) { const float mean = s[k] * (1.0f / 512.0f); q[k] = 0.f;
#pragma unroll
            for (int e = 0; e < 8; ++e) { v[k][e] -= mean; q[k] += v[k][e] * v[k][e]; } }
#pragma unroll
        for (int o = 1; o < 64; o <<= 1) {
#pragma unroll
            for (int k = 0; k < 4; ++k) q[k] += __shfl_xor(q[k], o); }
#pragma unroll
        for (int k = 0; k < 4; ++k) {
            const int row = 16 * wid + 4 * rq + k;
            const float rstd = __builtin_amdgcn_rsqf(q[k] * (1.0f / 512.0f) + EPS);
            u32x4 o;
#pragma unroll
            for (int e = 0; e < 4; ++e) o[e] = att::cvtpk(v[k][2 * e] * rstd * lg[2 * e] + lb[2 * e], v[k][2 * e + 1] * rstd * lg[2 * e + 1] + lb[2 * e + 1]);
            *(LAS u32x4*)(lds + (lane >> 3) * 16384 + row * 128 + (((lane & 7) ^ (((row >> 1) & 1) << 2)) << 4)) = o;
        }
    }
    __syncthreads();
    const int g = wid >> 1;
    const bf16* Wg = WSb + (size_t)g * 128 * 128;
    const LAS unsigned char* img = lds + wid * 16384;
    LAS unsigned char* stg = lds + GSTG + wid * GSTG_W;
    const int q4 = (lane & 15) >> 2, p4 = lane & 3, g1 = (lane >> 4) & 1;
#pragma unroll 1
    for (int tt = 0; tt < 4; ++tt) {
        u32x4 uu[2][2], ga[2][2];
#pragma unroll
        for (int dt = 0; dt < 2; ++dt)
#pragma unroll
            for (int k = 0; k < 2; ++k) { const int i = lane + 64 * k, row = i >> 2, ch = i & 3; const size_t off = (T0 + 32 * tt + row) * GW + 64 * wid + 32 * dt + ch * 8;
                uu[dt][k] = *(const GAS u32x4*)(U + off); ga[dt][k] = *(const GAS u32x4*)(GA + off); }
        const float bias = bs[g * 128 + 32 * tt + r32];
        f32x16 acc[2];
#pragma unroll
        for (int r = 0; r < 16; ++r) { acc[0][r] = 0.f; acc[1][r] = 0.f; }
        const int nks = 2 * tt + 2;
#pragma unroll 2
        for (int ks = 0; ks < nks; ++ks) {
            const bf16x8 a = *(const GAS bf16x8*)(Wg + (size_t)(32 * tt + r32) * 128 + 16 * ks + 8 * hi);
            v4i16 lo[2], hh[2];
#pragma unroll
            for (int dt = 0; dt < 2; ++dt) {
                const int vrow = 16 * ks + 8 * hi + q4, chn = 4 * dt + 2 * g1 + (p4 >> 1);
                const LAS unsigned char* vp = img + vrow * 128 + ((chn ^ (((vrow >> 1) & 1) << 2)) << 4) + 8 * (p4 & 1);
                lo[dt] = __builtin_amdgcn_ds_read_tr16_b64_v4i16((LAS v4i16*)vp);
                hh[dt] = __builtin_amdgcn_ds_read_tr16_b64_v4i16((LAS v4i16*)(vp + 512));
            }
#pragma unroll
            for (int dt = 0; dt < 2; ++dt) {
                const bf16x8 vf = (bf16x8){lo[dt][0], lo[dt][1], lo[dt][2], lo[dt][3], hh[dt][0], hh[dt][1], hh[dt][2], hh[dt][3]};
                acc[dt] = __builtin_amdgcn_mfma_f32_32x32x16_bf16(vf, a, acc[dt], 0, 0, 0);
            }
        }
#pragma unroll
        for (int dt = 0; dt < 2; ++dt) {
#pragma unroll
            for (int r4 = 0; r4 < 4; ++r4) { u32x2 w; w.x = att::cvtpk(acc[dt][4 * r4 + 0] + bias, acc[dt][4 * r4 + 1] + bias); w.y = att::cvtpk(acc[dt][4 * r4 + 2] + bias, acc[dt][4 * r4 + 3] + bias);
                *(LAS u32x2*)(stg + r32 * GSTG_ROW + (8 * r4 + 4 * hi) * 2) = w; }
            asm volatile("s_waitcnt lgkmcnt(0)" ::: "memory");
#pragma unroll
            for (int k = 0; k < 2; ++k) {
                const int i = lane + 64 * k, row = i >> 2, ch = i & 3;
                const u32x4 sv = *(const LAS u32x4*)(stg + row * GSTG_ROW + ch * 16);
                const u32x4 u4 = uu[dt][k], g4 = ga[dt][k];
                u32x4 o;
#pragma unroll
                for (int e = 0; e < 4; ++e) o[e] = att::cvtpk(gelu_f(bflo(u4[e])) * bflo(sv[e]) * silu_f(bflo(g4[e])), gelu_f(bfhi(u4[e])) * bfhi(sv[e]) * silu_f(bfhi(g4[e])));
                *(GAS u32x4*)(MIXED + (T0 + 32 * tt + row) * DM + AW + 64 * wid + 32 * dt + ch * 8) = o;
            }
            asm volatile("s_waitcnt lgkmcnt(0)" ::: "memory");
        }
    }
    __syncthreads();
}
}

struct Args { const void* in[16]; float* out; unsigned char* ws; int ph_lo, ph_hi, li, pad; };
__global__ void __launch_bounds__(NWAVES * 64, 2) mk_fwd(Args args) {
    extern __shared__ __attribute__((aligned(16))) unsigned char lds_raw[];
    LAS unsigned char* lds = (LAS unsigned char*)lds_raw;
    volatile LAS unsigned* MISC = (volatile LAS unsigned*)(lds + MISC_OFF);
    const int tid = threadIdx.x, lane = tid & 63, wave = __builtin_amdgcn_readfirstlane(tid >> 6);
    const int G = gridDim.x, bx = blockIdx.x, vcu = (G % 8 == 0) ? (bx % 8) * (G / 8) + bx / 8 : bx;
    unsigned char* ws = args.ws;
    gu32* ctl = (gu32*)(ws + WS_CTL);
    const float* x = (const float*)args.in[0]; const float* pin = (const float*)args.in[1]; const int* pos = (const int*)args.in[2];
    const float* g_in = (const float*)args.in[3]; const float* w_in = (const float*)args.in[4]; const float* qn = (const float*)args.in[5]; const float* kn = (const float*)args.in[6];
    const float* w_sp = (const float*)args.in[7]; const float* b_sp = (const float*)args.in[8]; const float* lng = (const float*)args.in[9]; const float* lnb = (const float*)args.in[10];
    const float* w_out = (const float*)args.in[11]; const float* g_ple = (const float*)args.in[12]; const float* w_g = (const float*)args.in[13]; const float* b_g = (const float*)args.in[14]; const float* w_p = (const float*)args.in[15];
    float* out = args.out;
    bf16 *Win_t = (bf16*)(ws + WS_WIN), *Wout_t = (bf16*)(ws + WS_WOUT), *Wg_t = (bf16*)(ws + WS_WG), *Wp_t = (bf16*)(ws + WS_WP), *WSb = (bf16*)(ws + WS_WSP);
    float* SS = (float*)(ws + WS_SS); float* DEN4 = (float*)(ws + WS_DEN4); float* DEN16 = (float*)(ws + WS_DEN16);
    bf16 *PB = (bf16*)(ws + WS_PB), *A = (bf16*)(ws + WS_A), *MIXED = (bf16*)(ws + WS_MIXED), *QB = (bf16*)(ws + WS_Q), *KB = (bf16*)(ws + WS_K), *VB = (bf16*)(ws + WS_V), *HB = (bf16*)(ws + WS_HB);
    bf16 *GB = (bf16*)(ws + WS_GB), *UB = (bf16*)(ws + WS_U), *VA = (bf16*)(ws + WS_VA), *GA = (bf16*)(ws + WS_GA), *PROJ = (bf16*)(ws + WS_PROJ), *P4 = (bf16*)(ws + WS_P4), *P16 = (bf16*)(ws + WS_P16);

    for (int u = tid; u < (LDS_BYTES - LDSCTL_OFF) / 4; u += NWAVES * 64) ((LAS unsigned*)(lds + LDSCTL_OFF))[u] = 0u;
    __syncthreads();
    XcdBarrier bar; bar.bar = (unsigned*)(ctl + CW_BAR); bar.x = 0; bar.st = nullptr;
    const bool multi = (args.ph_hi - args.ph_lo) > 1;
    if (multi) bar = xcd_barrier_post((unsigned*)(ctl + CW_BAR) + args.li * XCD_BAR_WORDS, MISC + 8);
#define GRID_BAR() xcd_barrier(bar)
    const int lo = args.ph_lo, hi_ph = args.ph_hi;
#define IN(k) (lo <= (k) && (k) < hi_ph)

    if (IN(0)) { {
        LAS float* scr = (LAS float*)(lds + RING_OFF + wave * 16384);
        const int gw = vcu * NWAVES + wave, NGW = G * NWAVES;
        constexpr int I_IN = (DM / 64) * (INC / 32), I_OUT = (DM / 64) * (DM / 32), I_G = I_OUT, I_P = (PLE / 64) * (DM / 32);
        constexpr int NITEMS = I_IN + I_OUT + I_G + I_P;
        for (int it = gw; it < NITEMS; it += NGW) {
            int r = it;
            if (r < I_IN) { p0_transpose_item<true>(w_in, DM, INC, Win_t, nullptr, scr, r, lane); continue; } r -= I_IN;
            if (r < I_OUT) { p0_transpose_item<false>(w_out, DM, DM, Wout_t, nullptr, scr, r, lane); continue; } r -= I_OUT;
            if (r < I_G) { p0_transpose_item<false>(w_g, DM, DM, Wg_t, g_ple, scr, r, lane); continue; } r -= I_G;
            p0_transpose_item<false>(w_p, PLE, DM, Wp_t, nullptr, scr, r, lane);
        }
        const int gt = vcu * NWAVES * 64 + tid, NGT = G * NWAVES * 64;
        for (int i = gt; i < 4 * 128 * 128; i += NGT) { const int s = i & 127, t = (i >> 7) & 127; WSb[i] = (bf16)f2bf(s <= t ? w_sp[i] : 0.0f); }
        f32x4 gv[4];
#pragma unroll
        for (int j = 0; j < 4; ++j) gv[j] = *((const GAS f32x4*)g_in + lane + 64 * j);
        for (int m = gw; m < M; m += NGW) {
            const GAS f32x4* xr = (const GAS f32x4*)(x + (size_t)m * DM) + lane;
            f32x4 v[4]; float s2 = 0.f;
#pragma unroll
            for (int j = 0; j < 4; ++j) { v[j] = xr[64 * j]; s2 += (v[j].x * v[j].x + v[j].y * v[j].y) + (v[j].z * v[j].z + v[j].w * v[j].w); }
            const float rstd = 1.0f / sqrtf(wave_sum(s2) * (1.0f / DM) + EPS);
            GAS unsigned long long* o8 = (GAS unsigned long long*)(A + (size_t)m * DM) + lane;
#pragma unroll
            for (int j = 0; j < 4; ++j) o8[64 * j] = (unsigned long long)pk2(v[j].x * rstd * gv[j].x, v[j].y * rstd * gv[j].y) | ((unsigned long long)pk2(v[j].z * rstd * gv[j].z, v[j].w * rstd * gv[j].w) << 32);
            const f32x4 pv = *((const GAS f32x4*)(pin + (size_t)m * PLE) + lane);
            *((GAS unsigned long long*)(PB + (size_t)m * PLE) + lane) = (unsigned long long)pk2(pv.x, pv.y) | ((unsigned long long)pk2(pv.z, pv.w) << 32);
        } }
        if (IN(1)) GRID_BAR();
    }
    if (IN(1)) {
        pg8::Gemm g{A, Win_t, M, INC, DM}; pg8::StaticOrder S; S.init(M, INC, G, bx);
        pg8::EpiIn E{QB, KB, VB, GB, UB, VA, GA, qn, kn, pos, 0.125f * 1.4426950408889634f};
        pg8::gemm_phase<pg8::EpiIn, pg8::StaticOrder, PG8_ALIGN, PG8_SP2>(lds + RING_OFF, g, S, E);
        if (IN(2)) GRID_BAR();
    }
    att::Tens AT{QB, KB, VB, P4, P16, DEN4, DEN16, GB, MIXED};
    if (IN(2)) att::attn_phase<false>(lds + RING_OFF, AT, vcu, G, qn, kn);
    if (IN(3)) {
        for (int uc = vcu; uc < M / 128; uc += G) gm::gmlp_unit(lds + RING_OFF, uc, VA, UB, GA, WSb, b_sp, lng, lnb, MIXED);
        if (IN(4)) GRID_BAR();
    }
    if (IN(4)) {
        att::attn_phase<true>(lds + RING_OFF, AT, vcu, G, qn, kn);
        if (IN(5)) GRID_BAR();
    }
    if (IN(5)) {
        { pg8::Gemm g{MIXED, Wout_t, M, DM, DM}; pg8::StaticOrder S; S.init(M, DM, G, bx);
          pg8::EpiOut E{x, HB, SS};
          pg8::gemm_phase<pg8::EpiOut, pg8::StaticOrder, PG8_ALIGN, PG8_SP2>(lds + RING_OFF, g, S, E); }
        { pg8::Gemm g{PB, Wp_t, M, DM, PLE}; pg8::StaticOrder S; S.init(M, DM, G, bx);
          pg8::EpiBf16<0> E{PROJ, DM, nullptr, 0, 0, 1.f};
          pg8::gemm_phase<pg8::EpiBf16<0>, pg8::StaticOrder, PG8_ALIGN, PG8_SP2>(lds + RING_OFF, g, S, E); }
        if (IN(6)) GRID_BAR();
    }
    if (IN(6)) {
        pg8::Gemm g{HB, Wg_t, M, DM, DM}; pg8::StaticOrder S; S.init(M, DM, G, bx);
        pg8::EpiFinal E{HB, out, PROJ, SS, b_g};
        pg8::gemm_phase<pg8::EpiFinal, pg8::StaticOrder, PG8_ALIGN, PG8_SP2>(lds + RING_OFF, g, S, E);
    }
#undef IN
#undef GRID_BAR
}

extern "C" void kernel_launch(void* const* d_in, const int* in_sizes, int n_in, void* d_out, int out_size, void* d_ws, size_t ws_size, hipStream_t stream) {
    static int grid = 0;
    if (grid == 0) {
        if (n_in != 16 || in_sizes[0] != M * DM || out_size != M * DM || ws_size < WS_END) { fprintf(stderr, "kernel_launch: unexpected shapes (n_in %d, in0 %d, out %d, ws %zu); nothing launched\n", n_in, n_in > 0 ? in_sizes[0] : -1, out_size, ws_size); grid = -1; return; }
        int dev = 0, cus = 0, per_cu = 0;
        if (hipGetDevice(&dev) != hipSuccess || hipDeviceGetAttribute(&cus, hipDeviceAttributeMultiprocessorCount, dev) != hipSuccess) { grid = -1; return; }
        if (hipFuncSetAttribute((const void*)mk_fwd, hipFuncAttributeMaxDynamicSharedMemorySize, LDS_BYTES) != hipSuccess) { fprintf(stderr, "kernel_launch: hipFuncSetAttribute failed\n"); grid = -1; return; }
        if (hipOccupancyMaxActiveBlocksPerMultiprocessor(&per_cu, (const void*)mk_fwd, NWAVES * 64, LDS_BYTES) != hipSuccess || per_cu < 1) fprintf(stderr, "kernel_launch: occupancy query reports %d per CU\n", per_cu);
        (void)hipGetLastError();
        grid = cus;
    }
    if (grid < 0) return;
    if (hipMemsetAsync((char*)d_ws + WS_CTL, 0, CTL_ZERO_BYTES, stream) != hipSuccess) return;
    Args a{};
    for (int i = 0; i < 16; ++i) a.in[i] = d_in[i];
    a.out = (float*)d_out; a.ws = (unsigned char*)d_ws;
    int los[8], his[8], nl = 0;
    if (PLAN == 0) { los[0] = 0; his[0] = NPHASE; nl = 1; }
    else if (PLAN == 1) { for (int k = 0; k < NPHASE; ++k) { los[k] = k; his[k] = k + 1; } nl = NPHASE; }
    else { const int k = PLAN - 10; los[0] = 0; his[0] = k + 1; los[1] = k; his[1] = k + 1; nl = 2; if (k + 1 < NPHASE) { los[2] = k + 1; his[2] = NPHASE; nl = 3; } }
    for (int li = 0; li < nl; ++li) {
        a.ph_lo = los[li]; a.ph_hi = his[li]; a.li = li;
        if (PLAN == 15 && li == 1) (void)hipMemsetAsync((char*)d_ws + WS_SS, 0, (size_t)M * 4, stream);
        hipLaunchKernelGGL(mk_fwd, dim3(grid), dim3(NWAVES * 64), LDS_BYTES, stream, a);
        const hipError_t le = hipPeekAtLastError();
        if (le != hipSuccess) { fprintf(stderr, "kernel_launch: launch %d failed: %s\n", li, hipGetErrorName(le)); break; }
    }
}
```

```cpp
#define MK_PLAN 0
#include <hip/hip_runtime.h>
#include <cstdio>
#include <cstdint>
namespace pg8 {
#define PG8_LAS __attribute__((address_space(3)))
typedef unsigned short bf16_t;
typedef short bf16x8 __attribute__((ext_vector_type(8)));
typedef float f32x4 __attribute__((ext_vector_type(4)));
typedef unsigned u32x4 __attribute__((ext_vector_type(4)));
constexpr int BM = 256, BK = 64, HALF = 128, HTB = HALF * BK * 2  , STAGE_BYTES = 8 * HTB, NXCD = 8, WGM = 8;

__host__ __device__ __forceinline__ int lds_byte(int r, int c) { const int st = (r >> 4) * 2 + (c >> 5), rr = r & 15, cc = c & 31, ob = rr * 64 + cc * 2; return st * 1024 + (ob ^ (((ob >> 9) & 1) << 5)); }
__host__ __device__ __forceinline__ void stage_rc(int b, int& R, int& C) { const int st = b / 1024, sb = b % 1024, swz = sb ^ (((sb >> 9) & 1) << 5); R = (st >> 1) * 16 + swz / 64; C = (st & 1) * 32 + (swz % 64) / 2; }
__host__ __device__ __forceinline__ int perm32(int rho) { const int n = rho >> 4, i = rho & 15; return 8 * (i >> 2) + 4 * n + (i & 3); }

struct Unit { int pm, pn; };
struct Gemm { const bf16_t* A; const bf16_t* Bt; int M, N, K; };

struct StaticOrder {
    int nM, nN, nwg, G, c;
    __host__ __device__ void init(int M, int N, int G_, int c_) { nM = M / BM; nN = N / BM; nwg = nM * nN; G = G_; c = c_; }
    __host__ __device__ bool next(int i, Unit& u) const {
        const long L = (long)i * G + c; if (L >= nwg) return false;
        int wgid = (int)L; { const int q = nwg / NXCD, r = nwg % NXCD, xcd = wgid % NXCD, off = wgid / NXCD; wgid = (xcd < r ? xcd * (q + 1) : r * (q + 1) + (xcd - r) * q) + off; }
        const int nig = WGM * nN, gid = wgid / nig, fm = gid * WGM, gsz = (nM - fm) < WGM ? (nM - fm) : WGM;
        u.pm = fm + ((wgid % nig) % gsz); u.pn = (wgid % nig) / gsz; return true;
    }
    __device__ __forceinline__ void a_ready(const Unit&) const {}
    __device__ __forceinline__ void done(const Unit&) const {}
};

typedef float f32x2c_t __attribute__((ext_vector_type(2))); typedef __bf16 bf16x2c_t __attribute__((ext_vector_type(2)));
__device__ __forceinline__ unsigned cvt_pk_bf16(float lo, float hi) { f32x2c_t v = {lo, hi}; bf16x2c_t b = __builtin_convertvector(v, bf16x2c_t); return __builtin_bit_cast(unsigned, b); }
typedef float f32x2 __attribute__((ext_vector_type(2)));
__device__ __forceinline__ f32x2 gelu_pk(f32x2 v) {
    const f32x2 av = __builtin_elementwise_abs(v), d = av * 0.2316418882f + 1.0f;
    f32x2 t; t.x = __builtin_amdgcn_rcpf(d.x); t.y = __builtin_amdgcn_rcpf(d.y);
    f32x2 q = t * 0.5307027145f + (-0.7265760135f); q = q * t + 0.7107068705f; q = q * t + (-0.142248368f); q = q * t + 0.127414796f; q = q * t;
    const f32x2 s = (v * v) * (-0.72134752044f);
    f32x2 e; e.x = __builtin_amdgcn_exp2f(s.x); e.y = __builtin_amdgcn_exp2f(s.y);
    const f32x2 m = v * (q * e), r = v - m;
    f32x2 o; o.x = v.x < 0.f ? m.x : r.x; o.y = v.y < 0.f ? m.y : r.y; return o;
}

template <int ACT  > struct EpiBf16 {
    static constexpr bool PERM = true, AFTER_DRAIN = false; static_assert(ACT == 0 || ACT == 1, "EpiBf16: ACT is 0 (none) or 1 (gelu_pk)");
    bf16_t* O; int ldc; const float* bias; int split_cols; size_t split_stride; float scale0;
    __device__ __forceinline__ void operator()(const f32x4 (&acc)[2][2][4][2], const Unit& u, int wr, int wc, int fr, int fq) const {
        const int row0 = u.pm * BM + wr * 64 + fr; int colt = u.pn * BM; bf16_t* base = O;
        float sc = 1.f; if (split_cols) { const int t = colt / split_cols; base += (size_t)t * split_stride; colt -= t * split_cols; if (t == 0) sc = scale0; }
        const int col0 = colt + wc * 32 + 8 * fq, bcol0 = u.pn * BM + wc * 32 + 8 * fq;
        f32x4 bv[2][2];
#pragma unroll
        for (int bj = 0; bj < 2; ++bj)
#pragma unroll
            for (int n = 0; n < 2; ++n) bv[bj][n] = bias ? *(const f32x4*)(bias + bcol0 + bj * HALF + 4 * n) : (f32x4){0.f, 0.f, 0.f, 0.f};
#pragma unroll
        for (int ai = 0; ai < 2; ++ai)
#pragma unroll
            for (int m = 0; m < 4; ++m) { bf16_t* rowp = base + (size_t)(row0 + ai * HALF + m * 16) * ldc + col0;
#pragma unroll
                for (int bj = 0; bj < 2; ++bj) { f32x4 v0 = acc[ai][bj][m][0] + bv[bj][0], v1 = acc[ai][bj][m][1] + bv[bj][1];
                    if (ACT == 1) { f32x2 a = gelu_pk((f32x2){v0[0], v0[1]}), b = gelu_pk((f32x2){v0[2], v0[3]}), c = gelu_pk((f32x2){v1[0], v1[1]}), d = gelu_pk((f32x2){v1[2], v1[3]});
                        v0 = (f32x4){a.x, a.y, b.x, b.y}; v1 = (f32x4){c.x, c.y, d.x, d.y}; }
                    v0 = v0 * sc; v1 = v1 * sc; u32x4 w; w.x = cvt_pk_bf16(v0[0], v0[1]); w.y = cvt_pk_bf16(v0[2], v0[3]); w.z = cvt_pk_bf16(v1[0], v1[1]); w.w = cvt_pk_bf16(v1[2], v1[3]);
                    *(u32x4*)(rowp + bj * HALF) = w; } }
    }
};
template <class Epi, class Sched, bool ALIGN_EPI = false, bool SP2 = false>
__device__ __forceinline__ void gemm_phase(PG8_LAS unsigned char* lds, const Gemm g, const Sched& S, const Epi& E) {
    const int tid = threadIdx.x, wid = __builtin_amdgcn_readfirstlane(tid >> 6), lane = tid & 63, wr = wid >> 2, wc = wid & 3, fr = lane & 15, fq = lane >> 4;
    const int K = g.K, nt = K / BK;
    unsigned voffA[2], voffB[2];
#pragma unroll
    for (int i = 0; i < 2; ++i) { int R, C; stage_rc(tid * 16 + i * 8192, R, C); const int Rb = Epi::PERM ? ((R & ~31) + perm32(R & 31)) : R;
        voffA[i] = (unsigned)(R * K + C) * 2u; voffB[i] = (unsigned)(Rb * K + C) * 2u; }
    const size_t kstep = (size_t)(BK * 2);
    const size_t hstep = (size_t)HALF * K * 2;
    const size_t tstep = 2 * hstep;
    const unsigned ldsw = (unsigned)wid * 1024u;
    const int aoff = lds_byte(wr * 64 + fr, fq * 8), boff = lds_byte(wc * 32 + fr, fq * 8);
#define PG8_SA(b, h) (((b) * 2 + (h)) * HTB)
#define PG8_SB(b, h) ((4 + (b) * 2 + (h)) * HTB)
#define PG8_STAGE(bufoff, gbase, voff) do { _Pragma("unroll") for (int _i = 0; _i < 2; ++_i) \
        __builtin_amdgcn_global_load_lds((const unsigned*)((const char*)(gbase) + (voff)[_i]), (PG8_LAS unsigned*)(lds + (bufoff) + ldsw + _i * 8192), 16, 0, 0); } while (0)
#define PG8_LDA(dst, b, h) do { _Pragma("unroll") for (int m = 0; m < 4; ++m) _Pragma("unroll") for (int k = 0; k < 2; ++k) dst[m][k] = *(const PG8_LAS bf16x8*)(lds + PG8_SA(b, h) + aoff + m * 2048 + k * 1024); } while (0)
#define PG8_LDB(dst, b, h) do { _Pragma("unroll") for (int n = 0; n < 2; ++n) _Pragma("unroll") for (int k = 0; k < 2; ++k) dst[n][k] = *(const PG8_LAS bf16x8*)(lds + PG8_SB(b, h) + boff + n * 2048 + k * 1024); } while (0)
#define PG8_MMA(ai, bj, At, Bt) do { __builtin_amdgcn_s_setprio(1); _Pragma("unroll") for (int m = 0; m < 4; ++m) _Pragma("unroll") for (int n = 0; n < 2; ++n) _Pragma("unroll") for (int k = 0; k < 2; ++k) \
        acc[ai][bj][m][n] = __builtin_amdgcn_mfma_f32_16x16x32_bf16(Bt[n][k], At[m][k], acc[ai][bj][m][n], 0, 0, 0); __builtin_amdgcn_s_setprio(0); } while (0)
#define PG8_WAIT_V(n) asm volatile("s_waitcnt vmcnt(" #n ")" ::: "memory")
#define PG8_WAIT_L(n) asm volatile("s_waitcnt lgkmcnt(" #n ")" ::: "memory")
#define PG8_BAR __builtin_amdgcn_s_barrier()
#define PG8_SCHED __builtin_amdgcn_sched_barrier(0)
    Unit cur, nxt; int ui = 0;
    if (!S.next(0, cur)) return;
    f32x4 acc[2][2][4][2];
#pragma unroll
    for (int a = 0; a < 2; ++a)
#pragma unroll
        for (int b = 0; b < 2; ++b)
#pragma unroll
            for (int m = 0; m < 4; ++m)
#pragma unroll
                for (int n = 0; n < 2; ++n) acc[a][b][m][n] = (f32x4){0.f, 0.f, 0.f, 0.f};
    bf16x8 At[4][2], B0[2][2], B1[2][2];
    const char* cA = (const char*)g.A + (size_t)cur.pm * tstep; const char* cB = (const char*)g.Bt + (size_t)cur.pn * tstep;
    S.a_ready(cur);
    if constexpr (SP2) {
        PG8_STAGE(PG8_SB(0, 0), cB, voffB); PG8_STAGE(PG8_SB(0, 1), cB + hstep, voffB); PG8_STAGE(PG8_SA(0, 0), cA, voffA); PG8_STAGE(PG8_SA(0, 1), cA + hstep, voffA);
        if (wr == 1) PG8_BAR;
        PG8_WAIT_V(2); PG8_BAR;
        PG8_STAGE(PG8_SB(1, 0), cB + kstep, voffB); PG8_STAGE(PG8_SA(1, 0), cA + kstep, voffA); PG8_STAGE(PG8_SB(1, 1), cB + hstep + kstep, voffB);
        PG8_WAIT_V(6); PG8_BAR;
    } else {
        PG8_STAGE(PG8_SB(0, 0), cB, voffB); PG8_STAGE(PG8_SA(0, 0), cA, voffA); PG8_STAGE(PG8_SB(0, 1), cB + hstep, voffB); PG8_STAGE(PG8_SA(0, 1), cA + hstep, voffA);
        if (wr == 1) PG8_BAR;
        PG8_WAIT_V(4); PG8_BAR;
        PG8_STAGE(PG8_SB(1, 0), cB + kstep, voffB); PG8_STAGE(PG8_SA(1, 0), cA + kstep, voffA); PG8_STAGE(PG8_SB(1, 1), cB + hstep + kstep, voffB);
        PG8_WAIT_V(6); PG8_BAR;
    }
    for (;;) {
        const bool has_next = S.next(ui + 1, nxt);
        const char* nA = has_next ? (const char*)g.A + (size_t)nxt.pm * tstep : cA; const char* nB = has_next ? (const char*)g.Bt + (size_t)nxt.pn * tstep : cB;
        for (int t = 0; t < nt; t += 2) {
            const bool last = (t == nt - 2);
            const char* a1 = cA + (size_t)(t + 1) * kstep;
            const char* a2 = last ? nA : cA + (size_t)(t + 2) * kstep; const char* b2 = last ? nB : cB + (size_t)(t + 2) * kstep;
            const char* a3 = a2 + kstep; const char* b3 = b2 + kstep;
            if (last && has_next) S.a_ready(nxt);
            if constexpr (SP2) {
            PG8_LDB(B0, 0, 0); PG8_LDB(B1, 0, 1); PG8_SCHED; PG8_LDA(At, 0, 0); PG8_STAGE(PG8_SA(1, 1), a1 + hstep, voffA);
            PG8_WAIT_V(8); PG8_WAIT_L(0); PG8_BAR; PG8_MMA(0, 0, At, B0); PG8_MMA(0, 1, At, B1); PG8_BAR; PG8_SCHED;
            PG8_LDA(At, 0, 1); PG8_STAGE(PG8_SB(0, 0), b2, voffB); PG8_STAGE(PG8_SB(0, 1), b2 + hstep, voffB); PG8_STAGE(PG8_SA(0, 0), a2, voffA);
            PG8_WAIT_V(8); PG8_WAIT_L(0); PG8_BAR; PG8_MMA(1, 0, At, B0); PG8_MMA(1, 1, At, B1); PG8_BAR; PG8_SCHED;
            PG8_LDB(B0, 1, 0); PG8_LDB(B1, 1, 1); PG8_SCHED; PG8_LDA(At, 1, 0); PG8_STAGE(PG8_SA(0, 1), a2 + hstep, voffA);
            PG8_WAIT_V(8); PG8_WAIT_L(0); PG8_BAR; PG8_MMA(0, 0, At, B0); PG8_MMA(0, 1, At, B1); PG8_BAR; PG8_SCHED;
            PG8_LDA(At, 1, 1); PG8_STAGE(PG8_SB(1, 0), b3, voffB); PG8_STAGE(PG8_SB(1, 1), b3 + hstep, voffB); PG8_STAGE(PG8_SA(1, 0), a3, voffA);
            PG8_WAIT_V(8); PG8_WAIT_L(0); PG8_BAR; PG8_MMA(1, 0, At, B0); PG8_MMA(1, 1, At, B1); PG8_BAR; PG8_SCHED;
            } else {
            PG8_LDB(B0, 0, 0); PG8_SCHED; PG8_LDA(At, 0, 0); PG8_STAGE(PG8_SA(1, 1), a1 + hstep, voffA);
            PG8_WAIT_L(8); PG8_BAR; PG8_WAIT_L(0); PG8_MMA(0, 0, At, B0); PG8_BAR; PG8_SCHED;
            PG8_LDB(B1, 0, 1); PG8_STAGE(PG8_SB(0, 0), b2, voffB);
            PG8_BAR; PG8_WAIT_L(0); PG8_MMA(0, 1, At, B1); PG8_BAR;
            PG8_LDA(At, 0, 1); PG8_STAGE(PG8_SA(0, 0), a2, voffA);
            PG8_BAR; PG8_WAIT_L(0); PG8_MMA(1, 0, At, B0); PG8_BAR; PG8_SCHED;
            PG8_STAGE(PG8_SB(0, 1), b2 + hstep, voffB);
            PG8_WAIT_V(6); PG8_BAR; PG8_MMA(1, 1, At, B1); PG8_BAR;
            PG8_LDB(B0, 1, 0); PG8_SCHED; PG8_LDA(At, 1, 0); PG8_STAGE(PG8_SA(0, 1), a2 + hstep, voffA);
            PG8_WAIT_L(8); PG8_BAR; PG8_WAIT_L(0); PG8_MMA(0, 0, At, B0); PG8_BAR; PG8_SCHED;
            PG8_LDB(B1, 1, 1); PG8_STAGE(PG8_SB(1, 0), b3, voffB);
            PG8_BAR; PG8_WAIT_L(0); PG8_MMA(0, 1, At, B1); PG8_BAR;
            PG8_LDA(At, 1, 1); PG8_STAGE(PG8_SA(1, 0), a3, voffA);
            PG8_BAR; PG8_WAIT_L(0); PG8_MMA(1, 0, At, B0); PG8_BAR; PG8_SCHED;
            PG8_STAGE(PG8_SB(1, 1), b3 + hstep, voffB);
            PG8_WAIT_V(6); PG8_BAR; PG8_MMA(1, 1, At, B1); PG8_BAR;
            }
        }
        if constexpr (ALIGN_EPI) { if (wr == 0) PG8_BAR; }
        if constexpr (!Epi::AFTER_DRAIN) { E(acc, cur, wr, wc, fr, fq); S.done(cur); }
        if (!has_next) break;
#pragma unroll
        for (int a = 0; a < 2; ++a)
#pragma unroll
            for (int b = 0; b < 2; ++b)
#pragma unroll
                for (int m = 0; m < 4; ++m)
#pragma unroll
                    for (int n = 0; n < 2; ++n) acc[a][b][m][n] = (f32x4){0.f, 0.f, 0.f, 0.f};
        cur = nxt; cA = nA; cB = nB; ++ui;
        if constexpr (ALIGN_EPI) { if (wr == 1) PG8_BAR; }
    }
    PG8_WAIT_V(0);
    if constexpr (!ALIGN_EPI) { if (wr == 0) PG8_BAR; }
    PG8_BAR;
    if constexpr (Epi::AFTER_DRAIN) { E.fused(acc, cur, wr, wc, fr, fq, lds, wid, lane); S.done(cur); }
#undef PG8_SA
#undef PG8_SB
#undef PG8_STAGE
#undef PG8_LDA
#undef PG8_LDB
#undef PG8_MMA
#undef PG8_WAIT_V
#undef PG8_WAIT_L
#undef PG8_BAR
#undef PG8_SCHED
}
}

#ifndef PG8_SP2
#define PG8_SP2 true
#endif
#ifndef PG8_ALIGN
#define PG8_ALIGN true
#endif
namespace pg8 {
constexpr float kLog2e = 1.4426950408889634f;
__device__ __forceinline__ float sigmoid_f(float x) { return __builtin_amdgcn_rcpf(1.0f + __builtin_amdgcn_exp2f(-kLog2e * x)); }
typedef unsigned u32x2 __attribute__((ext_vector_type(2)));

struct EpiIn {
    static constexpr bool PERM = true, AFTER_DRAIN = false;
    bf16_t *Q, *K, *V, *GB, *U, *VA, *GA; const float *qn, *kn; const int* pos; float qscale; int probe;
    __device__ __forceinline__ void operator()(const f32x4 (&acc)[2][2][4][2], const Unit& u, int wr, int wc, int fr, int fq) const {
        if (probe == 1) { asm volatile("" :: "v"(acc[0][0][0][0]), "v"(acc[1][1][3][1])); return; }
        const int pn = u.pn;
        const int row0 = u.pm * BM + wr * 64 + fr;
        if (pn < 4) {
            const bool isq = pn < 2;
            const int head = (pn & 1) * 4 + wc;
            const float* gs = isq ? qn : kn; bf16_t* dst = isq ? Q : K; const float sc = isq ? qscale : 1.0f;
            f32x4 g[2][2], invf[2];
#pragma unroll
            for (int bj = 0; bj < 2; ++bj)
#pragma unroll
                for (int n = 0; n < 2; ++n) g[bj][n] = *(const f32x4*)(gs + 32 * bj + 8 * fq + 4 * n);
#pragma unroll
            for (int n = 0; n < 2; ++n)
#pragma unroll
                for (int e = 0; e < 4; ++e) invf[n][e] = __builtin_amdgcn_exp2f(-(float)(8 * fq + 4 * n + e) * 0.41524101186092f) * 0.15915494309189535f;
#pragma unroll
            for (int ai = 0; ai < 2; ++ai)
#pragma unroll
                for (int m = 0; m < 4; ++m) {
                    const int row = row0 + ai * HALF + m * 16;
                    const float p = (float)pos[row];
                    float ss = 0.f;
#pragma unroll
                    for (int bj = 0; bj < 2; ++bj)
#pragma unroll
                        for (int n = 0; n < 2; ++n) { const f32x4 v = acc[ai][bj][m][n]; ss += (v[0] * v[0] + v[1] * v[1]) + (v[2] * v[2] + v[3] * v[3]); }
                    ss += __shfl_xor(ss, 16); ss += __shfl_xor(ss, 32);
                    const float rstd = __builtin_amdgcn_rsqf(ss * (1.0f / 64.0f) + 1e-6f) * sc;
                    u32x4 w0, w1;
#pragma unroll
                    for (int n = 0; n < 2; ++n) {
                        const f32x4 y0 = acc[ai][0][m][n] * rstd * g[0][n], y1 = acc[ai][1][m][n] * rstd * g[1][n];
                        f32x4 o0, o1;
#pragma unroll
                        for (int e = 0; e < 4; ++e) {
                            float rev = p * invf[n][e]; rev = __builtin_amdgcn_fractf(rev);
                            const float c = __builtin_amdgcn_cosf(rev), s = __builtin_amdgcn_sinf(rev);
                            o0[e] = y0[e] * c - y1[e] * s; o1[e] = y1[e] * c + y0[e] * s;
                        }
                        w0[2 * n] = cvt_pk_bf16(o0[0], o0[1]); w0[2 * n + 1] = cvt_pk_bf16(o0[2], o0[3]);
                        w1[2 * n] = cvt_pk_bf16(o1[0], o1[1]); w1[2 * n + 1] = cvt_pk_bf16(o1[2], o1[3]);
                    }
                    const int b = row >> 13, s = row & 8191;
                    bf16_t* rp = dst + ((size_t)((b * 8 + head) * 8192 + s)) * 64 + 8 * fq;
                    *(u32x4*)rp = w0; *(u32x4*)(rp + 32) = w1;
                }
        } else {
            const int sec = (pn - 4) >> 1;
            const int cbase = ((pn - 4) & 1) * 256 + wc * 32 + 8 * fq;
            bf16_t* base = sec == 1 ? GB : sec == 2 ? U : sec == 3 ? VA : GA;
#pragma unroll
            for (int ai = 0; ai < 2; ++ai)
#pragma unroll
                for (int m = 0; m < 4; ++m) {
                    const int row = row0 + ai * HALF + m * 16;
#pragma unroll
                    for (int bj = 0; bj < 2; ++bj) {
                        const f32x4 v0 = acc[ai][bj][m][0], v1 = acc[ai][bj][m][1];
                        u32x4 w; w.x = cvt_pk_bf16(v0[0], v0[1]); w.y = cvt_pk_bf16(v0[2], v0[3]); w.z = cvt_pk_bf16(v1[0], v1[1]); w.w = cvt_pk_bf16(v1[2], v1[3]);
                        const int col = cbase + bj * HALF;
                        if (sec == 0) { const int b = row >> 13, s = row & 8191, head = col >> 6, d = col & 63; *(u32x4*)(V + ((size_t)((b * 8 + head) * 8192 + s)) * 64 + d) = w; }
                        else *(u32x4*)(base + (size_t)row * 512 + col) = w;
                    }
                }
        }
    }
};
struct EpiOut {
    static constexpr bool PERM = false, AFTER_DRAIN = false;
    const float* x; bf16_t* hb; float* ss;
    __device__ __forceinline__ void operator()(const f32x4 (&acc)[2][2][4][2], const Unit& u, int wr, int wc, int fr, int fq) const {
        const int row0 = u.pm * BM + wr * 64 + fr, col0 = u.pn * BM + wc * 32 + 4 * fq;
#pragma unroll
        for (int ai = 0; ai < 2; ++ai) {
            f32x4 xv[4][2][2];
#pragma unroll
            for (int m = 0; m < 4; ++m)
#pragma unroll
                for (int bj = 0; bj < 2; ++bj)
#pragma unroll
                    for (int n = 0; n < 2; ++n) xv[m][bj][n] = *(const f32x4*)(x + (size_t)(row0 + ai * HALF + m * 16) * 1024 + col0 + bj * HALF + n * 16);
#pragma unroll
            for (int m = 0; m < 4; ++m) {
                const int row = row0 + ai * HALF + m * 16; float q = 0.f;
#pragma unroll
                for (int bj = 0; bj < 2; ++bj)
#pragma unroll
                    for (int n = 0; n < 2; ++n) {
                        const size_t off = (size_t)row * 1024 + col0 + bj * HALF + n * 16;
                        const f32x4 h = xv[m][bj][n] + acc[ai][bj][m][n];
                        q += (h[0] * h[0] + h[1] * h[1]) + (h[2] * h[2] + h[3] * h[3]);
                        u32x2 w; w.x = cvt_pk_bf16(h[0], h[1]); w.y = cvt_pk_bf16(h[2], h[3]);
                        *(u32x2*)(hb + off) = w;
                    }
                q += __shfl_xor(q, 16); q += __shfl_xor(q, 32);
                if (fq == 0) atomicAdd(ss + row, q);
            }
            asm volatile("" ::: "memory");
        }
    }
};
struct EpiFinal {
    static constexpr bool PERM = false, AFTER_DRAIN = false;
    const bf16_t* hb; float* out; const bf16_t* proj; const float* ss; const float* bg;
    __device__ __forceinline__ void operator()(const f32x4 (&acc)[2][2][4][2], const Unit& u, int wr, int wc, int fr, int fq) const {
        const int row0 = u.pm * BM + wr * 64 + fr, col0 = u.pn * BM + wc * 32 + 4 * fq;
        f32x4 bv[2][2];
#pragma unroll
        for (int bj = 0; bj < 2; ++bj)
#pragma unroll
            for (int n = 0; n < 2; ++n) bv[bj][n] = *(const f32x4*)(bg + col0 + bj * HALF + n * 16);
#pragma unroll
        for (int ai = 0; ai < 2; ++ai) {
            u32x2 hw[4][2][2], pw[4][2][2]; float sv[4];
#pragma unroll
            for (int m = 0; m < 4; ++m) {
                const int row = row0 + ai * HALF + m * 16; sv[m] = ss[row];
#pragma unroll
                for (int bj = 0; bj < 2; ++bj)
#pragma unroll
                    for (int n = 0; n < 2; ++n) { const size_t off = (size_t)row * 1024 + col0 + bj * HALF + n * 16; hw[m][bj][n] = *(const u32x2*)(hb + off); pw[m][bj][n] = *(const u32x2*)(proj + off); }
            }
#pragma unroll
            for (int m = 0; m < 4; ++m) {
                const int row = row0 + ai * HALF + m * 16;
                const float rstd = __builtin_amdgcn_rsqf(sv[m] * (1.0f / 1024.0f) + 1e-6f);
#pragma unroll
                for (int bj = 0; bj < 2; ++bj)
#pragma unroll
                    for (int n = 0; n < 2; ++n) {
                        const size_t off = (size_t)row * 1024 + col0 + bj * HALF + n * 16;
                        const f32x4 a = acc[ai][bj][m][n] * rstd + bv[bj][n];
                        const u32x2 h2 = hw[m][bj][n], p2 = pw[m][bj][n];
                        f32x4 o;
                        o[0] = __uint_as_float(h2.x << 16) + sigmoid_f(a[0]) * __uint_as_float(p2.x << 16);
                        o[1] = __uint_as_float(h2.x & 0xffff0000u) + sigmoid_f(a[1]) * __uint_as_float(p2.x & 0xffff0000u);
                        o[2] = __uint_as_float(h2.y << 16) + sigmoid_f(a[2]) * __uint_as_float(p2.y << 16);
                        o[3] = __uint_as_float(h2.y & 0xffff0000u) + sigmoid_f(a[3]) * __uint_as_float(p2.y & 0xffff0000u);
                        *(f32x4*)(out + off) = o;
                    }
            }
            asm volatile("" ::: "memory");
        }
    }
};
}
#define GAS __attribute__((address_space(1)))
#define LAS __attribute__((address_space(3)))
typedef unsigned short bf16;
typedef unsigned v4u __attribute__((ext_vector_type(4)));
typedef float f32x4 __attribute__((ext_vector_type(4)));
typedef short bf16x8 __attribute__((ext_vector_type(8)));
typedef GAS unsigned gu32;
typedef GAS unsigned long long gu64;
#define RLX_AGENT __ATOMIC_RELAXED, __HIP_MEMORY_SCOPE_AGENT
#define LDS_WAIT() asm volatile("s_waitcnt lgkmcnt(0)" ::: "memory")
#define VM_WAIT() asm volatile("s_waitcnt vmcnt(0)" ::: "memory")
__device__ __forceinline__ unsigned long long rt() { return __builtin_amdgcn_s_memrealtime(); }
__device__ __forceinline__ unsigned f2bf(float f) { unsigned u = __builtin_bit_cast(unsigned, f); return (u + 0x7fffu + ((u >> 16) & 1u)) >> 16; }
__device__ __forceinline__ unsigned pk2(float lo, float hi) { return f2bf(lo) | (f2bf(hi) << 16); }

#define XB_TMO      128
#define XB_XCNT(j)  (256  + 64 * (j))
#define XB_XSUB(j)  (1280 + 64 * (j))
#define XB_XGEN(j)  (2304 + 64 * (j))
#define XB_TOP      3328
#define XB_TOPGEN   3392
#define XCD_BAR_WORDS 3456
#define XB_SPIN_CAP (1u << 18)

__device__ __forceinline__ unsigned xb_ld(unsigned* p)              { return __hip_atomic_load(p, __ATOMIC_RELAXED, __HIP_MEMORY_SCOPE_AGENT); }
__device__ __forceinline__ unsigned xb_add(unsigned* p, unsigned v) { return __hip_atomic_fetch_add(p, v, __ATOMIC_RELAXED, __HIP_MEMORY_SCOPE_AGENT); }
__device__ __forceinline__ unsigned xb_xcc_id() { return (unsigned)__builtin_amdgcn_s_getreg((3 << 11) | 20) & 0xFu; }
#define XB_SPIN(cond, bar) do { unsigned _sp = 0; while (cond) { __builtin_amdgcn_s_sleep(1); \
    if ((++_sp & 255u) == 0u) { if (xb_ld(&(bar)[XB_TMO])) break; if (_sp > XB_SPIN_CAP) { atomicAdd(&(bar)[XB_TMO], 1u); break; } } } } while (0)

struct XcdBarrier {
    unsigned* bar; unsigned x;
    volatile LAS unsigned* st;
};

__device__ __forceinline__ XcdBarrier xcd_barrier_post(unsigned* bar, volatile LAS unsigned* st) {
    XcdBarrier b; b.bar = bar; b.x = xb_xcc_id(); b.st = st;
    if (threadIdx.x == 0) (void)xb_add(&bar[XB_XCNT(b.x)], 1u);
    return b;
}
__device__ __forceinline__ void xcd_barrier_complete(unsigned* bar, unsigned x, unsigned& nloc, unsigned& nx) {
    const unsigned G = gridDim.x * gridDim.y * gridDim.z;
    unsigned sum, cnt, mine, sp = 0u;
    for (;;) {
        sum = 0u; cnt = 0u; mine = 0u;
#pragma unroll
        for (unsigned j = 0; j < 16; ++j) { const unsigned c = xb_ld(&bar[XB_XCNT(j)]); sum += c; cnt += (c > 0u) ? 1u : 0u; mine = (j == x) ? c : mine; }
        if (sum == G) break;
        __builtin_amdgcn_s_sleep(1);
        if ((++sp & 255u) == 0u) { if (xb_ld(&bar[XB_TMO])) break; if (sp > XB_SPIN_CAP) { atomicAdd(&bar[XB_TMO], 1u); break; } }
    }
    nloc = mine > 0u ? mine : 1u; nx = cnt > 0u ? cnt : 1u;
}

__device__ __forceinline__ void xcd_barrier(const XcdBarrier& b) {
    asm volatile("s_waitcnt vmcnt(0)" ::: "memory");
    __syncthreads();
    if (threadIdx.x == 0) {
        unsigned* bar = b.bar;
        __builtin_amdgcn_s_waitcnt(0);
        unsigned nloc = b.st[0], nx = b.st[1];
        if (nloc == 0u) { xcd_barrier_complete(bar, b.x, nloc, nx); b.st[0] = nloc; b.st[1] = nx; }
        const unsigned old = xb_add(&bar[XB_XSUB(b.x)], 1u);
        const unsigned gen = old / nloc;
        if (old + 1u == (gen + 1u) * nloc) {
            __builtin_amdgcn_fence(__ATOMIC_RELEASE, "agent");
            asm volatile("s_waitcnt vmcnt(0)" ::: "memory");
            const unsigned og = xb_add(&bar[XB_TOP], 1u);
            const unsigned tg = og / nx;
            if (og + 1u == (tg + 1u) * nx) xb_add(&bar[XB_TOPGEN], 1u);
            else XB_SPIN(xb_ld(&bar[XB_TOPGEN]) == tg, bar);
            __builtin_amdgcn_fence(__ATOMIC_ACQUIRE, "agent");
            xb_add(&bar[XB_XGEN(b.x)], 1u);
            asm volatile("s_waitcnt vmcnt(0)" ::: "memory");
        } else {
            XB_SPIN(xb_ld(&bar[XB_XGEN(b.x)]) == gen, bar);
            __builtin_amdgcn_fence(__ATOMIC_ACQUIRE, "agent");
            asm volatile("s_waitcnt vmcnt(0)" ::: "memory");
        }
    }
    __syncthreads();
}
constexpr int NWAVES = 8;
#ifndef MK_PLAN
#define MK_PLAN 0
#endif
constexpr int PLAN = MK_PLAN;
constexpr int NPHASE = 7;

constexpr int BATCH = 4, SEQ = 8192, DM = 1024, NH = 8, HD = 64, AW = 512, GW = 512, INC = 3584, PLE = 256;
constexpr int M = BATCH * SEQ;
constexpr float EPS = 1e-6f;

constexpr size_t MiB = 1u << 20;
constexpr size_t WS_CTL = 0, CTL_ZERO_BYTES = 1 * MiB;
constexpr size_t WS_WIN = 2 * MiB;
constexpr size_t WS_WOUT = 10 * MiB;
constexpr size_t WS_WG = 12 * MiB;
constexpr size_t WS_WP = 14 * MiB;
constexpr size_t WS_WSP = 15 * MiB;
constexpr size_t WS_SS = 512 * 1024;
constexpr size_t WS_DEN4 = 16 * MiB, WS_DEN16 = 17 * MiB;
constexpr size_t WS_PB = 18 * MiB;
constexpr size_t WS_A = 34 * MiB;
constexpr size_t WS_MIXED = WS_A;
constexpr size_t WS_Q = 98 * MiB, WS_K = 130 * MiB, WS_V = 162 * MiB;
constexpr size_t WS_HB = WS_Q;
constexpr size_t WS_GB = 194 * MiB, WS_U = 226 * MiB, WS_VA = 258 * MiB, WS_GA = 290 * MiB;
constexpr size_t WS_PROJ = WS_GB;
constexpr size_t WS_P4 = 322 * MiB, WS_P16 = 354 * MiB;
constexpr size_t WS_END = 386 * MiB;
constexpr int CW_BAR = 4096;

constexpr int RING_OFF = 0, RING_BYTES = 151552;
constexpr int LDSCTL_OFF = RING_BYTES, MISC_OFF = LDSCTL_OFF + 320;
constexpr int LDS_BYTES = 155648;
static_assert(MISC_OFF + 128 <= LDS_BYTES, "LDS map");

__device__ __forceinline__ float wave_sum(float v) {
#pragma unroll
    for (int o = 1; o < 64; o <<= 1) v += __shfl_xor(v, o);
    return v;
}
__device__ __forceinline__ float wave_max(float v) {
#pragma unroll
    for (int o = 1; o < 64; o <<= 1) v = fmaxf(v, __shfl_xor(v, o));
    return v;
}
__device__ __forceinline__ float bflo(unsigned w) { return __uint_as_float(w << 16); }
__device__ __forceinline__ float bfhi(unsigned w) { return __uint_as_float(w & 0xffff0000u); }
template <bool QKPERM> __device__ __forceinline__ void p0_transpose_item(const float* W, int K, int N, bf16* WT, const float* kscale, LAS float* scr, int item, int lane) {
    const int nblk = N / 32, kb = item / nblk, nb = item % nblk, k0 = 64 * kb, n0 = 32 * nb;
#pragma unroll 8
    for (int i = 0; i < 32; ++i) { const int kk = 2 * i + (lane >> 5); float v = W[(size_t)(k0 + kk) * N + n0 + (lane & 31)]; if (kscale) v *= kscale[k0 + kk]; scr[kk * 33 + (lane & 31)] = v; }
    LDS_WAIT(); asm volatile("" ::: "memory");
    int r0 = n0;
    if (QKPERM && n0 < 1024) { const int pn = n0 >> 8, w = n0 & 255; r0 = pn * 256 + ((w >> 5) & 1) * 128 + (w >> 6) * 32; }
    const int c = lane & 7;
#pragma unroll
    for (int j = 0; j < 4; ++j) { const int n = (lane >> 3) + 8 * j; const LAS float* s = scr + (8 * c) * 33 + n;
        v4u o; o.x = pk2(s[0 * 33], s[1 * 33]); o.y = pk2(s[2 * 33], s[3 * 33]); o.z = pk2(s[4 * 33], s[5 * 33]); o.w = pk2(s[6 * 33], s[7 * 33]);
        *(GAS v4u*)(WT + (size_t)(r0 + n) * K + k0 + 8 * c) = o; }
    LDS_WAIT(); asm volatile("" ::: "memory");
}

namespace att {
typedef short bf16x8 __attribute__((ext_vector_type(8)));
typedef short v4i16 __attribute__((ext_vector_type(4)));
typedef float f32x16 __attribute__((ext_vector_type(16)));
typedef unsigned u32x4 __attribute__((ext_vector_type(4)));
typedef unsigned u32x2 __attribute__((ext_vector_type(2)));
constexpr int KOFF = 0, VOFF = 384 * 128, STG = 2 * 384 * 128, STG_ROW = 144, STG_W = 32 * STG_ROW, DSC = STG + 8 * STG_W, ATT_LDS = DSC + 8 * 32 * 4;
static_assert(ATT_LDS <= RING_BYTES, "attention LDS");
__device__ __forceinline__ int crow(int r, int hi) { return (r & 3) + 8 * (r >> 2) + 4 * hi; }
typedef float f32x2_t __attribute__((ext_vector_type(2))); typedef __bf16 bf16x2_t __attribute__((ext_vector_type(2)));
__device__ __forceinline__ unsigned cvtpk(float lo, float hi) { f32x2_t v = {lo, hi}; bf16x2_t b = __builtin_convertvector(v, bf16x2_t); return __builtin_bit_cast(unsigned, b); }
struct Tens { const bf16 *Q, *K, *V; bf16 *P4, *P16; float *D4, *D16; const bf16* GB; bf16* MIXED; };
struct Unit { int R, b, h, res, blk; };
struct Pre { u32x4 kv[6], vv[6]; bf16x8 qf[4]; };

__device__ __forceinline__ void unit_load(Pre& P, const Tens& T, const Unit& u, int tid, int wid, int r32, int hi) {
    const size_t hb = (size_t)(u.b * NH + u.h) * SEQ * HD;
    const int l0 = u.blk * 256, ch = tid & 7;
#pragma unroll
    for (int i = 0; i < 6; ++i) {
        const int row = (tid >> 3) + 64 * i, l = l0 - 128 + row;
        if (l >= 0) { const size_t off = hb + (size_t)(l * u.R + u.res) * HD + ch * 8; P.kv[i] = *(const GAS u32x4*)(T.K + off); P.vv[i] = *(const GAS u32x4*)(T.V + off); }
        else { P.kv[i] = (u32x4){0u, 0u, 0u, 0u}; P.vv[i] = (u32x4){0u, 0u, 0u, 0u}; }
    }
    const size_t qoff = hb + (size_t)((l0 + 32 * wid + r32) * u.R + u.res) * HD + 8 * hi;
#pragma unroll
    for (int ks = 0; ks < 4; ++ks) P.qf[ks] = *(const GAS bf16x8*)(T.Q + qoff + 16 * ks);
}
__device__ __forceinline__ void unit_stage(const Pre& P, LAS unsigned char* lds, int tid) {
    const int ch = tid & 7;
#pragma unroll
    for (int i = 0; i < 6; ++i) {
        const int row = (tid >> 3) + 64 * i;
        *(LAS u32x4*)(lds + KOFF + row * 128 + ((ch ^ ((row >> 1) & 7)) << 4)) = P.kv[i];
        *(LAS u32x4*)(lds + VOFF + row * 128 + ((ch ^ (((row >> 1) & 1) << 2)) << 4)) = P.vv[i];
    }
}
#define ATT_SB() __builtin_amdgcn_sched_barrier(0)
__device__ __forceinline__ float silu_f(float x) { return x * __builtin_amdgcn_rcpf(1.0f + __builtin_amdgcn_exp2f(-1.4426950408889634f * x)); }
template <bool MERGE> __device__ __forceinline__ void unit_compute(const bf16x8 (&qf)[4], LAS unsigned char* lds, const Tens& T, const Unit& u, float negM, int lane, int wid, int r32, int hi, int probe) {
    f32x16 oT[2]; float dsum = 0.f;
#pragma unroll
    for (int r = 0; r < 16; ++r) { oT[0][r] = 0.f; oT[1][r] = 0.f; }
    const int q4 = (lane & 15) >> 2, p4 = lane & 3, g1 = (lane >> 4) & 1;
    const int j0 = (probe == 3 || (probe >= 16 && (probe & 1))) ? 5 : (u.blk == 0) ? ((4 - wid) > 0 ? (4 - wid) : 0) : 0;
    bf16x8 kf[4];
    {   const int krow = 32 * (wid + (j0 > 4 ? 4 : j0)) + r32, ksw = (krow >> 1) & 7; const LAS unsigned char* kp = lds + KOFF + krow * 128;
#pragma unroll
        for (int ks = 0; ks < 4; ++ks) kf[ks] = *(const LAS bf16x8*)(kp + (((2 * ks + hi) ^ ksw) << 4)); }
#pragma unroll 1
    for (int j = j0; j < 5; ++j) {
        const int rb = 32 * (wid + j);
        f32x16 p;
#pragma unroll
        for (int r = 0; r < 16; ++r) p[r] = negM;
#pragma unroll
        for (int ks = 0; ks < 4; ++ks) p = __builtin_amdgcn_mfma_f32_32x32x16_bf16(kf[ks], qf[ks], p, 0, 0, 0);
        ATT_SB();
        v4i16 vlo[2][2], vhh[2][2];
#pragma unroll
        for (int s = 0; s < 2; ++s)
#pragma unroll
            for (int db = 0; db < 2; ++db) {
                const int vrow = rb + 16 * s + 4 * hi + q4, chn = 4 * db + 2 * g1 + (p4 >> 1);
                const LAS unsigned char* vp = lds + VOFF + vrow * 128 + ((chn ^ (((vrow >> 1) & 1) << 2)) << 4) + 8 * (p4 & 1);
                vlo[s][db] = __builtin_amdgcn_ds_read_tr16_b64_v4i16((LAS v4i16*)vp);
                vhh[s][db] = __builtin_amdgcn_ds_read_tr16_b64_v4i16((LAS v4i16*)(vp + 1024));
            }
        if (j < 4) { const int krow = rb + 32 + r32, ksw = (krow >> 1) & 7; const LAS unsigned char* kp = lds + KOFF + krow * 128;
#pragma unroll
            for (int ks = 0; ks < 4; ++ks) kf[ks] = *(const LAS bf16x8*)(kp + (((2 * ks + hi) ^ ksw) << 4)); }
        ATT_SB();
        if (j == 0) {
#pragma unroll
            for (int r = 0; r < 16; ++r) if (crow(r, hi) < r32) p[r] = -INFINITY;
        }
        if (j == 4) {
#pragma unroll
            for (int r = 0; r < 16; ++r) if (crow(r, hi) > r32) p[r] = -INFINITY;
        }
        float ds0 = 0.f, ds1 = 0.f;
#pragma unroll
        for (int r = 0; r < 16; r += 2) { p[r] = __builtin_amdgcn_exp2f(p[r]); p[r + 1] = __builtin_amdgcn_exp2f(p[r + 1]); ds0 += p[r]; ds1 += p[r + 1]; }
        dsum += ds0 + ds1;
        bf16x8 pa[2];
#pragma unroll
        for (int s = 0; s < 2; ++s) { u32x4 w; w.x = cvtpk(p[8 * s + 0], p[8 * s + 1]); w.y = cvtpk(p[8 * s + 2], p[8 * s + 3]); w.z = cvtpk(p[8 * s + 4], p[8 * s + 5]); w.w = cvtpk(p[8 * s + 6], p[8 * s + 7]); pa[s] = __builtin_bit_cast(bf16x8, w); }
        ATT_SB();
#pragma unroll
        for (int s = 0; s < 2; ++s)
#pragma unroll
            for (int db = 0; db < 2; ++db) {
                const bf16x8 vf = (bf16x8){vlo[s][db][0], vlo[s][db][1], vlo[s][db][2], vlo[s][db][3], vhh[s][db][0], vhh[s][db][1], vhh[s][db][2], vhh[s][db][3]};
                oT[db] = __builtin_amdgcn_mfma_f32_32x32x16_bf16(vf, pa[s], oT[db], 0, 0, 0);
            }
        ATT_SB();
    }
    const float dtot = dsum + __shfl_xor(dsum, 32);
    if (probe >= 16 && (probe & 8)) { asm volatile("" :: "v"(dtot), "v"(oT[0][0]), "v"(oT[1][15])); return; }
    LAS unsigned char* stg = lds + STG + wid * STG_W;
    LAS float* dsc = (LAS float*)(lds + DSC) + wid * 32;
    const int l0 = u.blk * 256;
    const size_t bhS = (size_t)(u.b * NH + u.h) * SEQ;
    u32x4 pa4[4], pa16[4], gg[4]; float d4[4], d16[4];
    if (MERGE) {
#pragma unroll
        for (int i = 0; i < 4; ++i) {
            const int row = (lane >> 3) + 8 * i, ch = lane & 7, t = l0 + 32 * wid + row;
            const size_t i4 = bhS + (size_t)((t & 3) * (SEQ / 4) + (t >> 2)), i16 = bhS + (size_t)((t & 15) * (SEQ / 16) + (t >> 4));
            pa4[i] = *(const GAS u32x4*)(T.P4 + i4 * HD + ch * 8); pa16[i] = *(const GAS u32x4*)(T.P16 + i16 * HD + ch * 8);
            gg[i] = *(const GAS u32x4*)(T.GB + ((size_t)u.b * SEQ + t) * AW + u.h * HD + ch * 8);
            d4[i] = T.D4[i4]; d16[i] = T.D16[i16];
        }
    }
#pragma unroll
    for (int db = 0; db < 2; ++db)
#pragma unroll
        for (int r4 = 0; r4 < 4; ++r4) { u32x2 w; w.x = cvtpk(oT[db][4 * r4 + 0], oT[db][4 * r4 + 1]); w.y = cvtpk(oT[db][4 * r4 + 2], oT[db][4 * r4 + 3]);
            *(LAS u32x2*)(stg + r32 * STG_ROW + (32 * db + 8 * r4 + 4 * hi) * 2) = w; }
    if (hi == 0) dsc[r32] = dtot;
    if (!MERGE) return;
    asm volatile("s_waitcnt lgkmcnt(0)" ::: "memory");
#pragma unroll
    for (int i = 0; i < 4; ++i) {
        const int row = (lane >> 3) + 8 * i, ch = lane & 7;
        const u32x4 v = *(const LAS u32x4*)(stg + row * STG_ROW + ch * 16);
        const size_t grow = (size_t)u.b * SEQ + (size_t)(l0 + 32 * wid + row);
        const u32x4 a = pa4[i], c = pa16[i], g = gg[i];
        const float d = dsc[row] + d4[i] + d16[i];
        const float inv = 1.0f / d;
        u32x4 o;
#pragma unroll
        for (int e = 0; e < 4; ++e) {
            const float x0 = (bflo(v[e]) + bflo(a[e]) + bflo(c[e])) * inv * silu_f(bflo(g[e]));
            const float x1 = (bfhi(v[e]) + bfhi(a[e]) + bfhi(c[e])) * inv * silu_f(bfhi(g[e]));
            o[e] = cvtpk(x0, x1);
        }
        *(GAS u32x4*)(T.MIXED + grow * DM + u.h * HD + ch * 8) = o;
    }
}
__device__ __forceinline__ void unit_flush(LAS unsigned char* lds, const Tens& T, const Unit& u, int lane, int wid) {
    const LAS unsigned char* stg = lds + STG + wid * STG_W;
    const LAS float* dsc = (const LAS float*)(lds + DSC) + wid * 32;
    const size_t base = (size_t)(u.b * NH + u.h) * SEQ + (size_t)(u.res * (SEQ / u.R) + u.blk * 256 + 32 * wid);
    bf16* Pd = (u.R == 4) ? T.P4 : T.P16; float* D = (u.R == 4) ? T.D4 : T.D16;
#pragma unroll
    for (int i = 0; i < 4; ++i) {
        const int row = (lane >> 3) + 8 * i, ch = lane & 7;
        const u32x4 v = *(const LAS u32x4*)(stg + row * STG_ROW + ch * 16);
        *(GAS u32x4*)(Pd + (base + row) * HD + ch * 8) = v;
    }
    if (lane < 32) D[base + lane] = dsc[lane];
    asm volatile("s_waitcnt lgkmcnt(0)" ::: "memory");
}
__device__ __forceinline__ Unit unit_of(int idx, bool merge) {
    Unit u;
    if (merge) { u.R = 1; const int bh = idx >> 5; u.b = bh >> 3; u.h = bh & 7; u.res = 0; u.blk = idx & 31; }
    else { const int br = idx >> 10, w = idx & 1023, bh = w >> 5, rb = w & 31; u.b = bh >> 3; u.h = bh & 7;
        if (br == 0) { u.R = 16; u.res = rb >> 1; u.blk = rb & 1; } else { u.R = 4; u.res = rb >> 3; u.blk = rb & 7; } }
    return u;
}
template <bool MERGE> __device__ __forceinline__ void attn_phase(LAS unsigned char* lds, const Tens& T, int vcu, int G, const float* qn, const float* kn, int probe) {
    const int tid = threadIdx.x, lane = tid & 63, r32 = lane & 31, hi = lane >> 5, wid = __builtin_amdgcn_readfirstlane(tid >> 6);
    const int total = (probe == 5) ? 0 : MERGE ? 1024 : 2048;
    const float mq = wave_max(fabsf(qn[lane])), mk = wave_max(fabsf(kn[lane]));
    const float negM = -8.0f * mq * mk * 1.4426950408889634f;
    Pre P;
    int idx = vcu;
    Unit uprev; bool have_prev = false;
    if (idx < total) { Unit u = unit_of(idx, MERGE); if (probe == 2) { u.b = 0; u.h = 0; } unit_load(P, T, u, tid, wid, r32, hi); }
    for (; idx < total; idx += G) {
        Unit u = unit_of(idx, MERGE); if (probe == 2) { u.b = 0; u.h = 0; }
        if (!(probe >= 16 && (probe & 4))) unit_stage(P, lds, tid);
        bf16x8 qf[4];
#pragma unroll
        for (int ks = 0; ks < 4; ++ks) qf[ks] = P.qf[ks];
        asm volatile("s_waitcnt lgkmcnt(0)" ::: "memory"); __builtin_amdgcn_s_barrier(); asm volatile("" ::: "memory");
        if (!MERGE && have_prev) unit_flush(lds, T, uprev, lane, wid);
        if (idx + G < total && probe != 4 && !(probe >= 16 && (probe & 2))) { Unit un = unit_of(idx + G, MERGE); if (probe == 2) { un.b = 0; un.h = 0; } unit_load(P, T, un, tid, wid, r32, hi); }
        unit_compute<MERGE>(qf, lds, T, u, negM, lane, wid, r32, hi, probe);
        asm volatile("s_waitcnt lgkmcnt(0)" ::: "memory"); __builtin_amdgcn_s_barrier(); asm volatile("" ::: "memory");
        uprev = u; have_prev = true;
    }
    if (!MERGE && have_prev) unit_flush(lds, T, uprev, lane, wid);
}
}

namespace gm {
typedef short bf16x8 __attribute__((ext_vector_type(8)));
typedef short v4i16 __attribute__((ext_vector_type(4)));
typedef float f32x16 __attribute__((ext_vector_type(16)));
typedef unsigned u32x4 __attribute__((ext_vector_type(4)));
typedef unsigned u32x2 __attribute__((ext_vector_type(2)));
constexpr int GSTG = 131072, GSTG_ROW = 80, GSTG_W = 32 * GSTG_ROW, GM_LDS = GSTG + 8 * GSTG_W;
static_assert(GM_LDS <= RING_BYTES, "gMLP LDS");
__device__ __forceinline__ float sig_f(float x) { return __builtin_amdgcn_rcpf(1.0f + __builtin_amdgcn_exp2f(-1.4426950408889634f * x)); }
__device__ __forceinline__ float gelu_f(float x) { return x * sig_f(x * (1.5957691216f + 0.0713548163f * x * x)); }
__device__ __forceinline__ float silu_f(float x) { return x * sig_f(x); }
__device__ __forceinline__ void gmlp_unit(LAS unsigned char* lds, int uc, const bf16* VA, const bf16* U, const bf16* GA, const bf16* WSb, const float* bs, const float* lng, const float* lnb, bf16* MIXED) {
    const int tid = threadIdx.x, lane = tid & 63, r32 = lane & 31, hi = lane >> 5, wid = __builtin_amdgcn_readfirstlane(tid >> 6);
    const size_t T0 = (size_t)uc * 128;
    float lg[8], lb[8];
#pragma unroll
    for (int e = 0; e < 8; ++e) { lg[e] = lng[lane * 8 + e]; lb[e] = lnb[lane * 8 + e]; }
#pragma unroll 1
    for (int rq = 0; rq < 4; ++rq) {
        u32x4 w[4];
#pragma unroll
        for (int k = 0; k < 4; ++k) w[k] = *(const GAS u32x4*)(VA + (T0 + 16 * wid + 4 * rq + k) * GW + lane * 8);
        float v[4][8], s[4];
#pragma unroll
        for (int k = 0; k < 4; ++k) { s[k] = 0.f;
#pragma unroll
            for (int e = 0; e < 4; ++e) { v[k][2 * e] = gelu_f(bflo(w[k][e])); v[k][2 * e + 1] = gelu_f(bfhi(w[k][e])); s[k] += v[k][2 * e] + v[k][2 * e + 1]; } }
#pragma unroll
        for (int o = 1; o < 64; o <<= 1) {
#pragma unroll
            for (int k = 0; k < 4; ++k) s[k] += __shfl_xor(s[k], o); }
        float q[4];
#pragma unroll
        for (int k = 0; k < 4; ++k) { const float mean = s[k] * (1.0f / 512.0f); q[k] = 0.f;
#pragma unroll
            for (int e = 0; e < 8; ++e) { v[k][e] -= mean; q[k] += v[k][e] * v[k][e]; } }
#pragma unroll
        for (int o = 1; o < 64; o <<= 1) {
#pragma unroll
            for (int k = 0; k < 4; ++k) q[k] += __shfl_xor(q[k], o); }
#pragma unroll
        for (int k = 0; k < 4; ++k) {
            const int row = 16 * wid + 4 * rq + k;
            const float rstd = __builtin_amdgcn_rsqf(q[k] * (1.0f / 512.0f) + EPS);
            u32x4 o;
#pragma unroll
            for (int e = 0; e < 4; ++e) o[e] = att::cvtpk(v[k][2 * e] * rstd * lg[2 * e] + lb[2 * e], v[k][2 * e + 1] * rstd * lg[2 * e + 1] + lb[2 * e + 1]);
            *(LAS u32x4*)(lds + (lane >> 3) * 16384 + row * 128 + (((lane & 7) ^ (((row >> 1) & 1) << 2)) << 4)) = o;
        }
    }
    __syncthreads();
    const int g = wid >> 1;
    const bf16* Wg = WSb + (size_t)g * 128 * 128;
    const LAS unsigned char* img = lds + wid * 16384;
    LAS unsigned char* stg = lds + GSTG + wid * GSTG_W;
    const int q4 = (lane & 15) >> 2, p4 = lane & 3, g1 = (lane >> 4) & 1;
#pragma unroll 1
    for (int tt = 0; tt < 4; ++tt) {
        u32x4 uu[2][2], ga[2][2];
#pragma unroll
        for (int dt = 0; dt < 2; ++dt)
#pragma unroll
            for (int k = 0; k < 2; ++k) { const int i = lane + 64 * k, row = i >> 2, ch = i & 3; const size_t off = (T0 + 32 * tt + row) * GW + 64 * wid + 32 * dt + ch * 8;
                uu[dt][k] = *(const GAS u32x4*)(U + off); ga[dt][k] = *(const GAS u32x4*)(GA + off); }
        const float bias = bs[g * 128 + 32 * tt + r32];
        f32x16 acc[2];
#pragma unroll
        for (int r = 0; r < 16; ++r) { acc[0][r] = 0.f; acc[1][r] = 0.f; }
        const int nks = 2 * tt + 2;
#pragma unroll 2
        for (int ks = 0; ks < nks; ++ks) {
            const bf16x8 a = *(const GAS bf16x8*)(Wg + (size_t)(32 * tt + r32) * 128 + 16 * ks + 8 * hi);
            v4i16 lo[2], hh[2];
#pragma unroll
            for (int dt = 0; dt < 2; ++dt) {
                const int vrow = 16 * ks + 8 * hi + q4, chn = 4 * dt + 2 * g1 + (p4 >> 1);
                const LAS unsigned char* vp = img + vrow * 128 + ((chn ^ (((vrow >> 1) & 1) << 2)) << 4) + 8 * (p4 & 1);
                lo[dt] = __builtin_amdgcn_ds_read_tr16_b64_v4i16((LAS v4i16*)vp);
                hh[dt] = __builtin_amdgcn_ds_read_tr16_b64_v4i16((LAS v4i16*)(vp + 512));
            }
#pragma unroll
            for (int dt = 0; dt < 2; ++dt) {
                const bf16x8 vf = (bf16x8){lo[dt][0], lo[dt][1], lo[dt][2], lo[dt][3], hh[dt][0], hh[dt][1], hh[dt][2], hh[dt][3]};
                acc[dt] = __builtin_amdgcn_mfma_f32_32x32x16_bf16(vf, a, acc[dt], 0, 0, 0);
            }
        }
#pragma unroll
        for (int dt = 0; dt < 2; ++dt) {
#pragma unroll
            for (int r4 = 0; r4 < 4; ++r4) { u32x2 w; w.x = att::cvtpk(acc[dt][4 * r4 + 0] + bias, acc[dt][4 * r4 + 1] + bias); w.y = att::cvtpk(acc[dt][4 * r4 + 2] + bias, acc[dt][4 * r4 + 3] + bias);
                *(LAS u32x2*)(stg + r32 * GSTG_ROW + (8 * r4 + 4 * hi) * 2) = w; }
            asm volatile("s_waitcnt lgkmcnt(0)" ::: "memory");
#pragma unroll
            for (int k = 0; k < 2; ++k) {
                const int i = lane + 64 * k, row = i >> 2, ch = i & 3;
                const u32x4 sv = *(const LAS u32x4*)(stg + row * GSTG_ROW + ch * 16);
                const u32x4 u4 = uu[dt][k], g4 = ga[dt][k];
                u32x4 o;
#pragma unroll
                for (int e = 0; e < 4; ++e) o[e] = att::cvtpk(gelu_f(bflo(u4[e])) * bflo(sv[e]) * silu_f(bflo(g4[e])), gelu_f(bfhi(u4[e])) * bfhi(sv[e]) * silu_f(bfhi(g4[e])));
                *(GAS u32x4*)(MIXED + (T0 + 32 * tt + row) * DM + AW + 64 * wid + 32 * dt + ch * 8) = o;
            }
            asm volatile("s_waitcnt lgkmcnt(0)" ::: "memory");
        }
    }
    __syncthreads();
}
}

struct Args { const void* in[16]; float* out; unsigned char* ws; int ph_lo, ph_hi, li, pad; };
template <int PROBE> __global__ void __launch_bounds__(NWAVES * 64, 2) mk_fwd(Args args) {
    extern __shared__ __attribute__((aligned(16))) unsigned char lds_raw[];
    LAS unsigned char* lds = (LAS unsigned char*)lds_raw;
    volatile LAS unsigned* MISC = (volatile LAS unsigned*)(lds + MISC_OFF);
    const int tid = threadIdx.x, lane = tid & 63, wave = __builtin_amdgcn_readfirstlane(tid >> 6);
    const int G = gridDim.x, bx = blockIdx.x, vcu = (G % 8 == 0) ? (bx % 8) * (G / 8) + bx / 8 : bx;
    unsigned char* ws = args.ws;
    gu32* ctl = (gu32*)(ws + WS_CTL);
    const float* x = (const float*)args.in[0]; const float* pin = (const float*)args.in[1]; const int* pos = (const int*)args.in[2];
    const float* g_in = (const float*)args.in[3]; const float* w_in = (const float*)args.in[4]; const float* qn = (const float*)args.in[5]; const float* kn = (const float*)args.in[6];
    const float* w_sp = (const float*)args.in[7]; const float* b_sp = (const float*)args.in[8]; const float* lng = (const float*)args.in[9]; const float* lnb = (const float*)args.in[10];
    const float* w_out = (const float*)args.in[11]; const float* g_ple = (const float*)args.in[12]; const float* w_g = (const float*)args.in[13]; const float* b_g = (const float*)args.in[14]; const float* w_p = (const float*)args.in[15];
    float* out = args.out;
    bf16 *Win_t = (bf16*)(ws + WS_WIN), *Wout_t = (bf16*)(ws + WS_WOUT), *Wg_t = (bf16*)(ws + WS_WG), *Wp_t = (bf16*)(ws + WS_WP), *WSb = (bf16*)(ws + WS_WSP);
    float* SS = (float*)(ws + WS_SS); float* DEN4 = (float*)(ws + WS_DEN4); float* DEN16 = (float*)(ws + WS_DEN16);
    bf16 *PB = (bf16*)(ws + WS_PB), *A = (bf16*)(ws + WS_A), *MIXED = (bf16*)(ws + WS_MIXED), *QB = (bf16*)(ws + WS_Q), *KB = (bf16*)(ws + WS_K), *VB = (bf16*)(ws + WS_V), *HB = (bf16*)(ws + WS_HB);
    bf16 *GB = (bf16*)(ws + WS_GB), *UB = (bf16*)(ws + WS_U), *VA = (bf16*)(ws + WS_VA), *GA = (bf16*)(ws + WS_GA), *PROJ = (bf16*)(ws + WS_PROJ), *P4 = (bf16*)(ws + WS_P4), *P16 = (bf16*)(ws + WS_P16);

    for (int u = tid; u < (LDS_BYTES - LDSCTL_OFF) / 4; u += NWAVES * 64) ((LAS unsigned*)(lds + LDSCTL_OFF))[u] = 0u;
    __syncthreads();
    XcdBarrier bar; bar.bar = (unsigned*)(ctl + CW_BAR); bar.x = 0; bar.st = nullptr;
    const bool multi = (args.ph_hi - args.ph_lo) > 1;
    if (multi) bar = xcd_barrier_post((unsigned*)(ctl + CW_BAR) + args.li * XCD_BAR_WORDS, MISC + 8);
#ifdef MK_DIAG
    int nst = 0;
#define STAMP() do { if (tid == 0) MISC[12 + nst] = (unsigned)__builtin_amdgcn_s_memrealtime(); ++nst; } while (0)
#else
#define STAMP() do {} while (0)
#endif
#define GRID_BAR() do { STAMP(); xcd_barrier(bar); STAMP(); } while (0)
    STAMP();
    const int lo = args.ph_lo, hi_ph = args.ph_hi;
#define IN(k) (lo <= (k) && (k) < hi_ph)

    if (IN(0)) { {
        LAS float* scr = (LAS float*)(lds + RING_OFF + wave * 16384);
        const int gw = vcu * NWAVES + wave, NGW = G * NWAVES;
        constexpr int I_IN = (DM / 64) * (INC / 32), I_OUT = (DM / 64) * (DM / 32), I_G = I_OUT, I_P = (PLE / 64) * (DM / 32);
        constexpr int NITEMS = I_IN + I_OUT + I_G + I_P;
        for (int it = vcu + G * wave; it < NITEMS; it += G * NWAVES) {
            int r = it;
            if (r < I_IN) { p0_transpose_item<true>(w_in, DM, INC, Win_t, nullptr, scr, r, lane); continue; } r -= I_IN;
            if (r < I_OUT) { p0_transpose_item<false>(w_out, DM, DM, Wout_t, nullptr, scr, r, lane); continue; } r -= I_OUT;
            if (r < I_G) { p0_transpose_item<false>(w_g, DM, DM, Wg_t, g_ple, scr, r, lane); continue; } r -= I_G;
            p0_transpose_item<false>(w_p, PLE, DM, Wp_t, nullptr, scr, r, lane);
        }
        const int gt = vcu * NWAVES * 64 + tid, NGT = G * NWAVES * 64;
        for (int i = gt; i < 4 * 128 * 128; i += NGT) { const int s = i & 127, t = (i >> 7) & 127; WSb[i] = (bf16)f2bf(s <= t ? w_sp[i] : 0.0f); }
        f32x4 gv[4];
#pragma unroll
        for (int j = 0; j < 4; ++j) gv[j] = *((const GAS f32x4*)g_in + lane + 64 * j);
        for (int m0 = 4 * gw; m0 < M; m0 += 4 * NGW) {
            f32x4 v[4][4], pv[4];
#pragma unroll
            for (int k = 0; k < 4; ++k) { const GAS f32x4* xr = (const GAS f32x4*)(x + (size_t)(m0 + k) * DM) + lane;
#pragma unroll
                for (int j = 0; j < 4; ++j) v[k][j] = __builtin_nontemporal_load(xr + 64 * j);
                pv[k] = __builtin_nontemporal_load((const GAS f32x4*)(pin + (size_t)(m0 + k) * PLE) + lane); }
            float s2[4];
#pragma unroll
            for (int k = 0; k < 4; ++k) { s2[k] = 0.f;
#pragma unroll
                for (int j = 0; j < 4; ++j) s2[k] += (v[k][j].x * v[k][j].x + v[k][j].y * v[k][j].y) + (v[k][j].z * v[k][j].z + v[k][j].w * v[k][j].w); }
#pragma unroll
            for (int o = 1; o < 64; o <<= 1) {
#pragma unroll
                for (int k = 0; k < 4; ++k) s2[k] += __shfl_xor(s2[k], o); }
#pragma unroll
            for (int k = 0; k < 4; ++k) {
                const float rstd = __builtin_amdgcn_rsqf(s2[k] * (1.0f / DM) + EPS);
                GAS unsigned long long* o8 = (GAS unsigned long long*)(A + (size_t)(m0 + k) * DM) + lane;
#pragma unroll
                for (int j = 0; j < 4; ++j) o8[64 * j] = (unsigned long long)att::cvtpk(v[k][j].x * rstd * gv[j].x, v[k][j].y * rstd * gv[j].y) | ((unsigned long long)att::cvtpk(v[k][j].z * rstd * gv[j].z, v[k][j].w * rstd * gv[j].w) << 32);
                *((GAS unsigned long long*)(PB + (size_t)(m0 + k) * PLE) + lane) = (unsigned long long)att::cvtpk(pv[k].x, pv[k].y) | ((unsigned long long)att::cvtpk(pv[k].z, pv[k].w) << 32);
            }
        } }
        if (IN(1)) GRID_BAR();
    }
    if (IN(1)) {
        pg8::Gemm g{A, Win_t, M, INC, DM}; pg8::StaticOrder S; S.init(M, INC, G, bx);
        pg8::EpiIn E{QB, KB, VB, GB, UB, VA, GA, qn, kn, pos, 0.125f * 1.4426950408889634f, PROBE};
        pg8::gemm_phase<pg8::EpiIn, pg8::StaticOrder, PG8_ALIGN, PG8_SP2>(lds + RING_OFF, g, S, E);
        if (IN(2)) GRID_BAR();
    }
    att::Tens AT{QB, KB, VB, P4, P16, DEN4, DEN16, GB, MIXED};
    if (PROBE >= 3) { AT.P4 = (bf16*)(ws + 400 * MiB); AT.P16 = (bf16*)(ws + 432 * MiB); AT.D4 = (float*)(ws + 464 * MiB); AT.D16 = (float*)(ws + 466 * MiB); AT.MIXED = (bf16*)(ws + 400 * MiB); }
    if (IN(2)) att::attn_phase<false>(lds + RING_OFF, AT, vcu, G, qn, kn, PROBE);
    if (IN(3)) {
        for (int uc = vcu; uc < M / 128; uc += G) gm::gmlp_unit(lds + RING_OFF, uc, VA, UB, GA, WSb, b_sp, lng, lnb, MIXED);
        if (IN(4)) GRID_BAR();
    }
    if (IN(4)) {
        att::attn_phase<true>(lds + RING_OFF, AT, vcu, G, qn, kn, PROBE);
        if (IN(5)) GRID_BAR();
    }
    if (IN(5)) {
        { pg8::Gemm g{MIXED, Wout_t, M, DM, DM}; pg8::StaticOrder S; S.init(M, DM, G, bx);
          pg8::EpiOut E{x, HB, SS};
          pg8::gemm_phase<pg8::EpiOut, pg8::StaticOrder, PG8_ALIGN, PG8_SP2>(lds + RING_OFF, g, S, E); }
        { pg8::Gemm g{PB, Wp_t, M, DM, PLE}; pg8::StaticOrder S; S.init(M, DM, G, bx);
          pg8::EpiBf16<0> E{PROJ, DM, nullptr, 0, 0, 1.f};
          pg8::gemm_phase<pg8::EpiBf16<0>, pg8::StaticOrder, PG8_ALIGN, PG8_SP2>(lds + RING_OFF, g, S, E); }
        if (IN(6)) GRID_BAR();
    }
    if (IN(6)) {
        pg8::Gemm g{HB, Wg_t, M, DM, DM}; pg8::StaticOrder S; S.init(M, DM, G, bx);
        pg8::EpiFinal E{HB, out, PROJ, SS, b_g};
        pg8::gemm_phase<pg8::EpiFinal, pg8::StaticOrder, PG8_ALIGN, PG8_SP2>(lds + RING_OFF, g, S, E);
    }
#ifdef MK_DIAG
    GRID_BAR();
    if (bx == MK_DIAG_BLOCK && tid == 0) { unsigned v; if (MK_DIAG == 100) { v = 0; for (int k = 1; k < 11; k += 2) v += MISC[12 + k + 1] - MISC[12 + k]; } else if (MK_DIAG == 101) v = MISC[12 + 11] - MISC[12 + 0]; else v = MISC[12 + MK_DIAG + 1] - MISC[12 + MK_DIAG]; out[0] = (float)v * 0.01f; }
#endif
#undef IN
#undef GRID_BAR
}

extern "C" void kernel_launch(void* const* d_in, const int* in_sizes, int n_in, void* d_out, int out_size, void* d_ws, size_t ws_size, hipStream_t stream) {
    static int grid = 0;
    if (grid == 0) {
        if (n_in != 16 || in_sizes[0] != M * DM || out_size != M * DM || ws_size < WS_END) { fprintf(stderr, "kernel_launch: unexpected shapes (n_in %d, in0 %d, out %d, ws %zu); nothing launched\n", n_in, n_in > 0 ? in_sizes[0] : -1, out_size, ws_size); grid = -1; return; }
        int dev = 0, cus = 0, per_cu = 0;
        if (hipGetDevice(&dev) != hipSuccess || hipDeviceGetAttribute(&cus, hipDeviceAttributeMultiprocessorCount, dev) != hipSuccess) { grid = -1; return; }
        if (hipFuncSetAttribute((const void*)mk_fwd<0>, hipFuncAttributeMaxDynamicSharedMemorySize, LDS_BYTES) != hipSuccess) { fprintf(stderr, "kernel_launch: hipFuncSetAttribute failed\n"); grid = -1; return; }
        if (hipOccupancyMaxActiveBlocksPerMultiprocessor(&per_cu, (const void*)mk_fwd<0>, NWAVES * 64, LDS_BYTES) != hipSuccess || per_cu < 1) fprintf(stderr, "kernel_launch: occupancy query reports %d per CU\n", per_cu);
        (void)hipGetLastError();
#ifdef MK_PROBE_FLAG
        (void)hipFuncSetAttribute((const void*)mk_fwd<MK_PROBE_FLAG>, hipFuncAttributeMaxDynamicSharedMemorySize, LDS_BYTES);
#endif
        grid = cus;
    }
    if (grid < 0) return;
    if (hipMemsetAsync((char*)d_ws + WS_CTL, 0, CTL_ZERO_BYTES, stream) != hipSuccess) return;
    Args a{};
    for (int i = 0; i < 16; ++i) a.in[i] = d_in[i];
    a.out = (float*)d_out; a.ws = (unsigned char*)d_ws;
    int los[8], his[8], nl = 0;
    if (PLAN == 0) { los[0] = 0; his[0] = NPHASE; nl = 1; }
    else if (PLAN == 1) { for (int k = 0; k < NPHASE; ++k) { los[k] = k; his[k] = k + 1; } nl = NPHASE; }
    else { const int k = PLAN - 10; los[0] = 0; his[0] = k + 1; los[1] = k; his[1] = k + 1; nl = 2; if (k + 1 < NPHASE) { los[2] = k + 1; his[2] = NPHASE; nl = 3; } }
    for (int li = 0; li < nl; ++li) {
        a.ph_lo = los[li]; a.ph_hi = his[li]; a.li = li;
        if (PLAN == 15 && li == 1) (void)hipMemsetAsync((char*)d_ws + WS_SS, 0, (size_t)M * 4, stream);
#ifdef MK_PROBE_FLAG
        if (PLAN >= 10 && li == 1) hipLaunchKernelGGL(mk_fwd<MK_PROBE_FLAG>, dim3(grid), dim3(NWAVES * 64), LDS_BYTES, stream, a); else
#endif
        hipLaunchKernelGGL(mk_fwd<0>, dim3(grid), dim3(NWAVES * 64), LDS_BYTES, stream, a);
        const hipError_t le = hipPeekAtLastError();
        if (le != hipSuccess) { fprintf(stderr, "kernel_launch: launch %d failed: %s\n", li, hipGetErrorName(le)); break; }
    }
}
```
